# Optimizing an MI355X kernel written in HIP

```python
import math
import jax, jax.numpy as jnp
from jax import lax
import numpy as np

D_MODEL = 1024
BATCH = 2
SEQ = 16384
DEPTH = 2

CHUNK = 64
QBLOCK = 128
HEAD_DIM = 64
POOL_GROUPS = 4
POOL_CH = D_MODEL // 16
POOL_W = POOL_GROUPS * POOL_CH
POOL_WINDOWS = (2, 4, 8, 16)
SB_W = 3 * D_MODEL // 8
SB_HEADS = SB_W // HEAD_DIM
RET_W = 3 * D_MODEL // 8
RET_HEADS = RET_W // HEAD_DIM
MIX_W = POOL_W + SB_W + RET_W
IN_W = POOL_W + 3 * SB_W + 4 * RET_W
ROPE_BASE = 10000.0
N_EXPERTS = 32
TOP_K = 4
D_FF = D_MODEL
SWIGLU_LIMIT = 7.0
SWIGLU_ALPHA = 1.702
EXPERT_BLOCK = 256
DN_ALPHA = (2.0 * DEPTH) ** 0.25
DN_BETA = (8.0 * DEPTH) ** -0.25
LN_EPS = 1e-5

kernel_name = "hybrid_pool_stickbreak_retention_moe_deepnorm"


def layer_norm(x, g, b):
    xf = x.astype(jnp.float32)
    mu = jnp.mean(xf, axis=-1, keepdims=True)
    var = jnp.mean(jnp.square(xf - mu), axis=-1, keepdims=True)
    y = (xf - mu) * lax.rsqrt(var + LN_EPS) * g.astype(jnp.float32) + b.astype(jnp.float32)
    return y.astype(x.dtype)


def rotary(x, pos):
    half = x.shape[-1] // 2
    inv = ROPE_BASE ** (-jnp.arange(half, dtype=jnp.float32) / half)
    ang = pos[:, None] * inv[None, :]
    cos = jnp.cos(ang)[None, :, None, :]
    sin = jnp.sin(ang)[None, :, None, :]
    x1, x2 = x[..., :half], x[..., half:]
    return jnp.concatenate([x1 * cos - x2 * sin, x1 * sin + x2 * cos], axis=-1)


def pool_mixer(u, pool_w, pool_scale):
    S_ = u.shape[1]
    uf = u.astype(jnp.float32)
    cs = jnp.pad(jnp.cumsum(uf, axis=1), ((0, 0), (1, 0), (0, 0)))
    t = jnp.arange(S_)
    outs = []
    for g, w in enumerate(POOL_WINDOWS):
        sl = slice(g * POOL_CH, (g + 1) * POOL_CH)
        lo = jnp.maximum(t + 1 - w, 0)
        win_sum = cs[:, 1:, sl] - cs[:, lo, sl]
        cnt = jnp.minimum(t + 1, w).astype(jnp.float32)
        outs.append(win_sum / cnt[None, :, None] - uf[..., sl])
    pooled = jnp.stack(outs, axis=2)
    mixed = jnp.einsum('bsgc,gcd->bsgd', pooled, pool_w.astype(jnp.float32))
    out = mixed.reshape(u.shape) * pool_scale.astype(jnp.float32)
    return out.astype(u.dtype)


def stick_breaking(q, k, v):
    B_, S_, H, dh = q.shape
    qf = jnp.moveaxis(q, 1, 2).astype(jnp.float32) * (dh ** -0.5)
    kf = jnp.moveaxis(k, 1, 2).astype(jnp.float32)
    vf = jnp.moveaxis(v, 1, 2).astype(jnp.float32)
    nqb = S_ // QBLOCK
    j = jnp.arange(QBLOCK)
    tri_in = (j[:, None] >= j[None, :]).astype(jnp.float32)
    outs = []
    for bi in range(nqb):
        nb = bi + 1
        L = nb * QBLOCK
        qi = qf[:, :, bi * QBLOCK:L]
        z = jnp.einsum('bhqd,bhkd->bhqk', qi, kf[:, :, :L])
        qpos = bi * QBLOCK + j
        causal = jnp.arange(L)[None, :] < qpos[:, None]
        lk = jnp.where(causal, jax.nn.log_sigmoid(-z), 0.0).reshape(B_, H, QBLOCK, nb, QBLOCK)
        r_in = jnp.einsum('bhqnj,js->bhqns', lk, tri_in)
        n = jnp.arange(nb)
        tri_blk = (n[:, None] > n[None, :]).astype(jnp.float32)
        carry = jnp.einsum('bhqm,mn->bhqn', jnp.sum(lk, axis=-1), tri_blk)
        r = (r_in + carry[..., None]).reshape(B_, H, QBLOCK, L)
        a = jnp.where(causal, jnp.exp(z + r), 0.0)
        outs.append(jnp.einsum('bhqk,bhkd->bhqd', a, vf[:, :, :L]))
    o = jnp.concatenate(outs, axis=2)
    o = jnp.moveaxis(o, 1, 2).reshape(B_, S_, H * dh)
    return o.astype(q.dtype)


def retention(q, k, v, gate, norm_g):
    B_, S_, H, dh = q.shape
    pos = jnp.arange(S_, dtype=jnp.float32)
    qf = rotary(q.astype(jnp.float32), pos)
    kf = rotary(k.astype(jnp.float32), pos) * (dh ** -0.5)
    vf = v.astype(jnp.float32)
    log_g = jnp.log(1.0 - 2.0 ** (-5.0 - jnp.arange(H, dtype=jnp.float32)))
    nc = S_ // CHUNK
    qc = qf.reshape(B_, nc, CHUNK, H, dh)
    kc = kf.reshape(B_, nc, CHUNK, H, dh)
    vc = vf.reshape(B_, nc, CHUNK, H, dh)
    c = jnp.arange(CHUNK, dtype=jnp.float32)
    dmat = jnp.exp(jnp.abs(c[:, None] - c[None, :])[None] * log_g[:, None, None])
    scores = jnp.einsum('bnchd,bnmhd->bnhcm', qc, kc) * dmat
    o_intra = jnp.einsum('bnhcm,bnmhd->bnchd', scores, vc)
    v_dec = vc * jnp.exp((CHUNK - 1 - c)[:, None] * log_g[None, :])[None, None, :, :, None]
    kv = jnp.einsum('bnchd,bnche->bnhde', kc, v_dec)
    g_chunk = jnp.exp(CHUNK * log_g)[:, None, None]

    def step(r, kv_n):
        return g_chunk * r + kv_n, r

    _, r_prev = lax.scan(step, jnp.zeros((B_, H, dh, dh), jnp.float32), jnp.moveaxis(kv, 1, 0))
    r_prev = jnp.moveaxis(r_prev, 0, 1)
    xi = jnp.exp((c + 1.0)[:, None] * log_g[None, :])
    o_inter = jnp.einsum('bnchd,bnhde->bnche', qc * xi[None, None, :, :, None], r_prev)
    o = (o_intra + o_inter).reshape(B_, S_, H, dh)
    mu = jnp.mean(o, axis=-1, keepdims=True)
    var = jnp.mean(jnp.square(o - mu), axis=-1, keepdims=True)
    o = (o - mu) * lax.rsqrt(var + LN_EPS) * norm_g.astype(jnp.float32).reshape(H, dh)
    out = jax.nn.silu(gate.astype(jnp.float32)) * o.reshape(B_, S_, H * dh)
    return out.astype(q.dtype)


def expert_ffn(x2, router_w, router_b, w_gate_up, b_gate_up, w_down, b_down):
    N, D = x2.shape
    logits = (x2 @ router_w).astype(jnp.float32) + router_b.astype(jnp.float32)
    top_v, top_i = lax.top_k(logits, TOP_K)
    gates = jax.nn.softmax(top_v, axis=-1)
    A = N * TOP_K
    flat_e = top_i.reshape(-1).astype(jnp.int32)
    flat_g = gates.reshape(-1)
    flat_tok = jnp.arange(A, dtype=jnp.int32) // TOP_K
    order = jnp.argsort(flat_e)
    se, stok, sg = flat_e[order], flat_tok[order], flat_g[order]
    counts = jnp.zeros((N_EXPERTS,), jnp.int32).at[flat_e].add(1)
    starts = jnp.cumsum(counts) - counts
    pcounts = (counts + EXPERT_BLOCK - 1) // EXPERT_BLOCK * EXPERT_BLOCK
    pends = jnp.cumsum(pcounts)
    pstarts = pends - pcounts
    dest = pstarts[se] + (jnp.arange(A, dtype=jnp.int32) - starts[se])
    P = A + N_EXPERTS * EXPERT_BLOCK
    NB = P // EXPERT_BLOCK
    row_tok = jnp.zeros((P,), jnp.int32).at[dest].set(stok)
    row_gate = jnp.zeros((P,), jnp.float32).at[dest].set(sg)
    blk_e = jnp.minimum(jnp.searchsorted(pends, jnp.arange(NB, dtype=jnp.int32) * EXPERT_BLOCK, side='right'), N_EXPERTS - 1)

    def expert_block(args):
        e, toks = args
        xb = x2[toks]
        h = xb @ w_gate_up[e] + b_gate_up[e]
        g, up = h[:, :D_FF], h[:, D_FF:]
        g = jnp.minimum(g, SWIGLU_LIMIT)
        up = jnp.clip(up, -SWIGLU_LIMIT, SWIGLU_LIMIT)
        act = (up + 1.0) * (g * jax.nn.sigmoid(SWIGLU_ALPHA * g))
        return act @ w_down[e] + b_down[e]

    y = lax.map(expert_block, (blk_e, row_tok.reshape(NB, EXPERT_BLOCK)))
    y = y.reshape(P, D) * row_gate[:, None].astype(y.dtype)
    return jnp.zeros_like(x2).at[row_tok].add(y)


def hybrid_layer(x, w_in, b_in, pool_w, pool_scale, ret_norm_g, w_out, b_out, ln1_g, ln1_b,
                 router_w, router_b, w_gate_up, b_gate_up, w_down, b_down, ln2_g, ln2_b):
    B_, S_, D = x.shape
    h = x @ w_in + b_in
    o0 = POOL_W
    u_pool = h[..., :o0]
    sb_q = h[..., o0:o0 + SB_W].reshape(B_, S_, SB_HEADS, HEAD_DIM)
    sb_k = h[..., o0 + SB_W:o0 + 2 * SB_W].reshape(B_, S_, SB_HEADS, HEAD_DIM)
    sb_v = h[..., o0 + 2 * SB_W:o0 + 3 * SB_W].reshape(B_, S_, SB_HEADS, HEAD_DIM)
    o1 = o0 + 3 * SB_W
    r_q = h[..., o1:o1 + RET_W].reshape(B_, S_, RET_HEADS, HEAD_DIM)
    r_k = h[..., o1 + RET_W:o1 + 2 * RET_W].reshape(B_, S_, RET_HEADS, HEAD_DIM)
    r_v = h[..., o1 + 2 * RET_W:o1 + 3 * RET_W].reshape(B_, S_, RET_HEADS, HEAD_DIM)
    r_g = h[..., o1 + 3 * RET_W:o1 + 4 * RET_W]
    mixed = jnp.concatenate([
        pool_mixer(u_pool, pool_w, pool_scale),
        stick_breaking(sb_q, sb_k, sb_v),
        retention(r_q, r_k, r_v, r_g, ret_norm_g),
    ], axis=-1)
    x = layer_norm(DN_ALPHA * x + (mixed @ w_out + b_out), ln1_g, ln1_b)
    ffn = expert_ffn(x.reshape(B_ * S_, D), router_w, router_b, w_gate_up, b_gate_up, w_down, b_down)
    x = layer_norm(DN_ALPHA * x + ffn.reshape(B_, S_, D), ln2_g, ln2_b)
    return x


def setup_inputs(seed: int = 0) -> dict:
    key = jax.random.key(seed)
    ks = jax.random.split(key, 20)
    nrm = jax.random.normal
    col_scale = jnp.concatenate([
        jnp.full((POOL_W,), DN_BETA), jnp.ones((2 * SB_W,)), jnp.full((SB_W,), DN_BETA),
        jnp.ones((2 * RET_W,)), jnp.full((RET_W,), DN_BETA), jnp.ones((RET_W,)),
    ]).astype(jnp.float32)
    return {
        "x": nrm(ks[0], (BATCH, SEQ, D_MODEL), jnp.float32),
        "w_in": nrm(ks[1], (DEPTH, D_MODEL, IN_W), jnp.float32) * (D_MODEL ** -0.5) * col_scale,
        "b_in": 0.02 * nrm(ks[2], (DEPTH, IN_W), jnp.float32),
        "pool_w": nrm(ks[3], (DEPTH, POOL_GROUPS, POOL_CH, POOL_CH), jnp.float32) * (POOL_CH ** -0.5),
        "pool_scale": 1.0 + 0.1 * nrm(ks[4], (DEPTH, POOL_W), jnp.float32),
        "ret_norm_g": 1.0 + 0.1 * nrm(ks[5], (DEPTH, RET_W), jnp.float32),
        "w_out": nrm(ks[6], (DEPTH, MIX_W, D_MODEL), jnp.float32) * (MIX_W ** -0.5) * DN_BETA,
        "b_out": 0.02 * nrm(ks[7], (DEPTH, D_MODEL), jnp.float32),
        "ln1_g": 1.0 + 0.02 * nrm(ks[8], (DEPTH, D_MODEL), jnp.float32),
        "ln1_b": 0.02 * nrm(ks[9], (DEPTH, D_MODEL), jnp.float32),
        "router_w": nrm(ks[10], (DEPTH, D_MODEL, N_EXPERTS), jnp.float32) * (D_MODEL ** -0.5),
        "router_b": 0.01 * nrm(ks[11], (DEPTH, N_EXPERTS), jnp.float32),
        "w_gate_up": nrm(ks[12], (DEPTH, N_EXPERTS, D_MODEL, 2 * D_FF), jnp.float32) * (D_MODEL ** -0.5) * DN_BETA,
        "b_gate_up": 0.02 * nrm(ks[13], (DEPTH, N_EXPERTS, 2 * D_FF), jnp.float32),
        "w_down": nrm(ks[14], (DEPTH, N_EXPERTS, D_FF, D_MODEL), jnp.float32) * (D_FF ** -0.5) * DN_BETA,
        "b_down": 0.02 * nrm(ks[15], (DEPTH, N_EXPERTS, D_MODEL), jnp.float32),
        "ln2_g": 1.0 + 0.02 * nrm(ks[16], (DEPTH, D_MODEL), jnp.float32),
        "ln2_b": 0.02 * nrm(ks[17], (DEPTH, D_MODEL), jnp.float32),
    }


def reference(x, w_in, b_in, pool_w, pool_scale, ret_norm_g, w_out, b_out, ln1_g, ln1_b,
              router_w, router_b, w_gate_up, b_gate_up, w_down, b_down, ln2_g, ln2_b):
    for l in range(DEPTH):
        x = hybrid_layer(x, w_in[l], b_in[l], pool_w[l], pool_scale[l], ret_norm_g[l], w_out[l], b_out[l],
                         ln1_g[l], ln1_b[l], router_w[l], router_b[l], w_gate_up[l], b_gate_up[l],
                         w_down[l], b_down[l], ln2_g[l], ln2_b[l])
    return x
```

```cpp
#include <hip/hip_runtime.h>
#include <hip/hip_cooperative_groups.h>
#include <cstdio>
#include <cstdint>
namespace cg = cooperative_groups;

#define LAS __attribute__((address_space(3)))
typedef unsigned short bf16_t;
typedef short bf16x8 __attribute__((ext_vector_type(8)));
typedef float f32x4 __attribute__((ext_vector_type(4)));
typedef unsigned u32x4 __attribute__((ext_vector_type(4)));
typedef unsigned u32x2 __attribute__((ext_vector_type(2)));
typedef int i32x8 __attribute__((ext_vector_type(8)));
typedef int i32x4 __attribute__((ext_vector_type(4)));

constexpr int NTOK = 32768, SEQ = 16384, DM = 1024, INW = 2944, INWP = 3072, NEXP = 32, DEPTH = 2;
constexpr int NCHUNK = 256;
constexpr int C_SBQ = 256, C_SBK = 640, C_SBV = 1024, C_RQ = 1408, C_RK = 1792, C_RV = 2176, C_RG = 2560;
constexpr int M_SB = 256, M_RET = 640;
constexpr float DN_ALPHA = 1.41421356237f, LN_EPS = 1e-5f;
constexpr int PROWS = 131072 + NEXP * 256;
constexpr float W8_SCALE = 64.0f, ACT8_SCALE = 8.0f;
constexpr int LDS_BYTES = 147456 + 64, TAB_OFF = 131072, XBST_OFF = 147456;

constexpr size_t WS_CTL = 0;
constexpr size_t WS_BPAD = 4096;
constexpr size_t WS_ROT = 32768;
constexpr size_t WS_WIN = WS_ROT + 2ull * 16384 * 32 * 4;
constexpr size_t WS_WOUT = WS_WIN + 2ull * INWP * 1024 * 2;
constexpr size_t WS_WGU = WS_WOUT + 2ull * 1024 * 1024 * 2;
constexpr size_t WS_WDN = WS_WGU + 2ull * 32 * 2048 * 1024 * 2;
constexpr size_t WS_XB = WS_WDN + 2ull * 32 * 1024 * 1024 * 2;
constexpr size_t WS_HBUF = WS_XB + (size_t)NTOK * 1024 * 2;
constexpr size_t WS_MIXED = WS_HBUF + (size_t)NTOK * INWP * 2;
constexpr size_t WS_KV = WS_MIXED + (size_t)NTOK * 1024 * 2;
constexpr size_t WS_YPRE = WS_KV + 12ull * 256 * 4096 * 4;
constexpr size_t WS_X1B = WS_YPRE + (size_t)NTOK * 1024 * 4;
constexpr size_t WS_XS = WS_X1B + (size_t)NTOK * 1024 * 2;
constexpr size_t WS_ACT = WS_XS + (size_t)PROWS * 1024 * 2;
constexpr size_t WS_YBUF = WS_ACT + (size_t)PROWS * 1024 * 2;
constexpr size_t WS_SLOTE = WS_YBUF + 131072ull * 1024 * 2;
constexpr size_t WS_SLOTPOS = WS_SLOTE + 131072ull * 4;
constexpr size_t WS_SLOTG = WS_SLOTPOS + 131072ull * 4;
constexpr size_t WS_ROWSLOT = WS_SLOTG + 131072ull * 4;
constexpr size_t WS_POOLW = WS_ROWSLOT + (size_t)PROWS * 4;
constexpr size_t WS_ROWGATE = WS_POOLW + 2ull * 4 * 4096 * 2;
constexpr size_t WS_BAR = WS_ROWGATE + (size_t)PROWS * 4;
constexpr size_t WS_X1Q = WS_XS;
constexpr size_t WS_RPREV = WS_XS + (128ull << 20);
constexpr size_t WS_END = WS_BAR + 16384;

__device__ __forceinline__ unsigned pk2(float lo, float hi) { unsigned r; asm("v_cvt_pk_bf16_f32 %0, %1, %2" : "=v"(r) : "v"(lo), "v"(hi)); return r; }
__device__ __forceinline__ unsigned pk4_fp8(float a, float b, float c, float d) { int w = 0; w = __builtin_amdgcn_cvt_pk_fp8_f32(a, b, w, false); w = __builtin_amdgcn_cvt_pk_fp8_f32(c, d, w, true); return (unsigned)w; }
__device__ __forceinline__ float bflo(unsigned u) { return __uint_as_float(u << 16); }
__device__ __forceinline__ float bfhi(unsigned u) { return __uint_as_float(u & 0xffff0000u); }
__device__ __forceinline__ float bf1(bf16_t b) { return __uint_as_float((unsigned)b << 16); }
__device__ __forceinline__ float sx(float v, int m, int lane) { return __builtin_bit_cast(float, __builtin_amdgcn_ds_bpermute((lane ^ m) << 2, __builtin_bit_cast(int, v))); }
__device__ __forceinline__ float sl(float v, int src) { return __builtin_bit_cast(float, __builtin_amdgcn_ds_bpermute(src << 2, __builtin_bit_cast(int, v))); }
__device__ __forceinline__ float wave_sum(float v, int lane) {
#pragma unroll
    for (int o = 1; o < 64; o <<= 1) v += sx(v, o, lane);
    return v;
}
__device__ __forceinline__ void lds_fence() { asm volatile("s_waitcnt lgkmcnt(0)" ::: "memory"); }
__device__ __forceinline__ bf16x8 as_bf16x8(u32x4 v) { return __builtin_bit_cast(bf16x8, v); }

namespace pg8 {
constexpr int BM = 256, BK = 64, HALF = 128, HTB = HALF * BK * 2, STAGE_BYTES = 8 * HTB, NXCD = 8, WGM = 8;
__device__ __forceinline__ int lds_byte(int r, int c) { const int st = (r >> 4) * 2 + (c >> 5), rr = r & 15, cc = c & 31, ob = rr * 64 + cc * 2; return st * 1024 + (ob ^ (((ob >> 9) & 1) << 5)); }
__device__ __forceinline__ void stage_rc(int b, int& R, int& C) { const int st = b / 1024, sb = b % 1024, swz = sb ^ (((sb >> 9) & 1) << 5); R = (st >> 1) * 16 + swz / 64; C = (st & 1) * 32 + (swz % 64) / 2; }
__device__ __forceinline__ int perm32(int rho) { const int n = rho >> 4, i = rho & 15; return 8 * (i >> 2) + 4 * n + (i & 3); }

struct Unit { int pm, pn, e; };

struct DenseOrder {
    static constexpr LAS const unsigned short* rt = nullptr;
    const char* A; const char* Bt; int nM, nN, nwg, G, c; size_t tstep;
    __device__ void init(const void* A_, const void* Bt_, int M, int N, int K, int G_, int c_) { A = (const char*)A_; Bt = (const char*)Bt_; nM = M / BM; nN = N / BM; nwg = nM * nN; G = G_; c = c_; tstep = (size_t)BM * K * 2; }
    __device__ bool next(int i, Unit& u) const {
        const long L = (long)i * G + c; if (L >= nwg) return false;
        int wgid = (int)L; { const int q = nwg / NXCD, r = nwg % NXCD, xcd = wgid % NXCD, off = wgid / NXCD; wgid = (xcd < r ? xcd * (q + 1) : r * (q + 1) + (xcd - r) * q) + off; }
        const int nig = WGM * nN, gid = wgid / nig, fm = gid * WGM, gsz = (nM - fm) < WGM ? (nM - fm) : WGM;
        u.pm = fm + ((wgid % nig) % gsz); u.pn = (wgid % nig) / gsz; u.e = 0; return true;
    }
    __device__ __forceinline__ const char* aptr(const Unit& u) const { return A + (size_t)u.pm * tstep; }
    __device__ __forceinline__ const char* bptr(const Unit& u) const { return Bt + (size_t)u.pn * tstep; }
};
struct GroupedOrder {
    const char* A; const char* Bt; LAS const int* mpre; LAS const unsigned short* rt; int nN, G, c, MT; size_t tstep, estep;
    __device__ void init(const void* A_, const void* Bt_, LAS const int* mpre_, int N, int K, int G_, int c_) { rt = nullptr; A = (const char*)A_; Bt = (const char*)Bt_; mpre = mpre_; nN = N / BM; G = G_; c = c_; MT = __builtin_amdgcn_readfirstlane(mpre_[NEXP]); tstep = (size_t)BM * K * 2; estep = (size_t)N * K * 2; }
    __device__ bool next(int i, Unit& u) const {
        int mt, pn;
        if ((G & 7) == 0 && (G >> 3) % nN == 0) { const int xcd = c & 7, j = c >> 3, per = (G >> 3) / nN; pn = j % nN; mt = (i * per + j / nN) * 8 + xcd; }
        else { const int L = i * G + c; mt = L / nN; pn = L % nN; }
        if (mt >= MT) return false;
        u.pm = mt; u.pn = pn; int e = 0;
        for (int j = 1; j < NEXP; ++j) e += (mpre[j] <= mt) ? 1 : 0;
        u.e = __builtin_amdgcn_readfirstlane(e); return true;
    }
    __device__ __forceinline__ const char* aptr(const Unit& u) const { return rt ? A : A + (size_t)u.pm * tstep; }
    __device__ __forceinline__ const char* bptr(const Unit& u) const { return Bt + (size_t)u.e * estep + (size_t)u.pn * tstep; }
};

template <bool GATHER, bool FP8, class Epi, class Sched>
__device__ __forceinline__ void gemm_phase(LAS unsigned char* lds, const int tid, const int K, const Sched& S, const Epi& E) {
    const int wid = __builtin_amdgcn_readfirstlane(tid >> 6), lane = tid & 63, wr = wid >> 2, wc = wid & 3, fr = lane & 15, fq = lane >> 4;
    const int nt = K / BK;
    int R0, C0; stage_rc(tid * 16, R0, C0); const int Rb0 = Epi::PERM ? ((R0 & ~31) + perm32(R0 & 31)) : R0;
    unsigned voffA[2], voffB[2];
    voffA[0] = (unsigned)(R0 * K + C0) * 2u; voffA[1] = voffA[0] + (unsigned)(64 * K * 2);
    voffB[0] = (unsigned)(Rb0 * 128 + C0 * 2); voffB[1] = voffB[0] + 64u * 128u;
    const size_t kstepB = 32768, hstepB = 16384;
    const size_t kstep = (size_t)(BK * 2);
    const size_t hstep = (size_t)HALF * K * 2;
    const size_t hsA = GATHER ? (size_t)0 : hstep;
    unsigned oC[2][2], o2[2][2];
#define PG8_LOADOFF(dst, round) do { _Pragma("unroll") for (int _i = 0; _i < 2; ++_i) \
        _Pragma("unroll") for (int _h = 0; _h < 2; ++_h) dst[_h][_i] = GATHER ? ((unsigned)S.rt[(round) * 256 + _h * 128 + _i * 64 + R0] * (unsigned)(K * 2) + (unsigned)(C0 * 2)) : voffA[_i]; } while (0)
    const unsigned ldsw = (unsigned)wid * 1024u;
    const int aoff = lds_byte(wr * 64 + fr, fq * 8), boff = lds_byte(wc * 32 + fr, fq * 8);
#define PG8_SA(b, h) (((b) * 2 + (h)) * HTB)
#define PG8_SB(b, h) ((4 + (b) * 2 + (h)) * HTB)
#define PG8_STAGE(bufoff, gbase, voff) do { _Pragma("unroll") for (int _i = 0; _i < 2; ++_i) \
        __builtin_amdgcn_global_load_lds((const unsigned*)((const char*)(gbase) + (voff)[_i]), (LAS unsigned*)(lds + (bufoff) + ldsw + _i * 8192), 16, 0, 0); } while (0)
#define PG8_LD16(off) (*(const LAS i32x4*)(lds + (off)))
#define PG8_LDA(dst, b, h) do { if constexpr (FP8) { _Pragma("unroll") for (int m = 0; m < 4; ++m) dst##8[m] = __builtin_shufflevector(PG8_LD16(PG8_SA(b, h) + aoff + m * 2048), PG8_LD16(PG8_SA(b, h) + aoff + m * 2048 + 1024), 0, 1, 2, 3, 4, 5, 6, 7); } \
        else { _Pragma("unroll") for (int m = 0; m < 4; ++m) _Pragma("unroll") for (int k = 0; k < 2; ++k) dst[m][k] = *(const LAS bf16x8*)(lds + PG8_SA(b, h) + aoff + m * 2048 + k * 1024); } } while (0)
#define PG8_LDB(dst, b, h) do { if constexpr (FP8) { _Pragma("unroll") for (int n = 0; n < 2; ++n) dst##8[n] = __builtin_shufflevector(PG8_LD16(PG8_SB(b, h) + boff + n * 2048), PG8_LD16(PG8_SB(b, h) + boff + n * 2048 + 1024), 0, 1, 2, 3, 4, 5, 6, 7); } \
        else { _Pragma("unroll") for (int n = 0; n < 2; ++n) _Pragma("unroll") for (int k = 0; k < 2; ++k) dst[n][k] = *(const LAS bf16x8*)(lds + PG8_SB(b, h) + boff + n * 2048 + k * 1024); } } while (0)
#define PG8_MMA(ai, bj, At, Bt) do { __builtin_amdgcn_s_setprio(1); \
        if constexpr (FP8) { _Pragma("unroll") for (int m = 0; m < 4; ++m) _Pragma("unroll") for (int n = 0; n < 2; ++n) \
            asm volatile("v_mfma_scale_f32_16x16x128_f8f6f4 %0, %1, %2, %0, %3, %3 op_sel_hi:[0,0,0]" : "+v"(acc[ai][bj][m][n]) : "v"(Bt##8[n]), "v"(At##8[m]), "v"(sc8)); } \
        else { _Pragma("unroll") for (int m = 0; m < 4; ++m) _Pragma("unroll") for (int n = 0; n < 2; ++n) _Pragma("unroll") for (int k = 0; k < 2; ++k) \
            acc[ai][bj][m][n] = __builtin_amdgcn_mfma_f32_16x16x32_bf16(Bt[n][k], At[m][k], acc[ai][bj][m][n], 0, 0, 0); } \
        __builtin_amdgcn_s_setprio(0); } while (0)
#define PG8_WAIT_V(n) asm volatile("s_waitcnt vmcnt(" #n ")" ::: "memory")
#define PG8_WAIT_L(n) asm volatile("s_waitcnt lgkmcnt(" #n ")" ::: "memory")
#define PG8_BAR __builtin_amdgcn_s_barrier()
#define PG8_SCHED __builtin_amdgcn_sched_barrier(0)
    Unit cur, nxt; int ui = 0;
    if (!S.next(0, cur)) return;
    int sc8 = 0x7f; asm volatile("" : "+v"(sc8));
    float zf = 0.f; asm volatile("" : "+v"(zf));
    f32x4 acc[2][2][4][2];
#pragma unroll
    for (int a = 0; a < 2; ++a)
#pragma unroll
        for (int b = 0; b < 2; ++b)
#pragma unroll
            for (int m = 0; m < 4; ++m)
#pragma unroll
                for (int n = 0; n < 2; ++n) acc[a][b][m][n] = (f32x4){zf, zf, zf, zf};
    bf16x8 At[4][2], B0[2][2], B1[2][2];
    i32x8 At8[4], B08[2], B18[2];
    const char* cA = S.aptr(cur); const char* cB = S.bptr(cur);
    PG8_LOADOFF(oC, 0);
#pragma unroll
    for (int _h = 0; _h < 2; ++_h)
#pragma unroll
        for (int _i = 0; _i < 2; ++_i) o2[_h][_i] = oC[_h][_i];
    PG8_STAGE(PG8_SB(0, 0), cB, voffB); PG8_STAGE(PG8_SB(0, 1), cB + hstepB, voffB); PG8_STAGE(PG8_SA(0, 0), cA, oC[0]); PG8_STAGE(PG8_SA(0, 1), cA + hsA, oC[1]);
    if (wr == 1) PG8_BAR;
    PG8_WAIT_V(2); PG8_BAR;
    PG8_STAGE(PG8_SB(1, 0), cB + kstepB, voffB); PG8_STAGE(PG8_SA(1, 0), cA + kstep, oC[0]); PG8_STAGE(PG8_SB(1, 1), cB + hstepB + kstepB, voffB);
    PG8_WAIT_V(6); PG8_BAR;
    for (;;) {
        const bool has_next = S.next(ui + 1, nxt);
        const char* nA = has_next ? S.aptr(nxt) : cA; const char* nB = has_next ? S.bptr(nxt) : cB;
#pragma unroll 1
        for (int t = 0; t < nt; t += 2) {
            const bool last = (t == nt - 2);
            if (GATHER && last && has_next) { PG8_LOADOFF(o2, ui + 1); }
            const char* a1 = cA + (size_t)(t + 1) * kstep;
            const char* a2 = last ? nA : cA + (size_t)(t + 2) * kstep; const char* b2 = last ? nB : cB + (size_t)(t + 2) * kstepB;
            const char* a3 = a2 + kstep; const char* b3 = b2 + kstepB;
            PG8_LDB(B0, 0, 0); PG8_LDB(B1, 0, 1); PG8_SCHED; PG8_LDA(At, 0, 0); PG8_STAGE(PG8_SA(1, 1), a1 + hsA, oC[1]);
            PG8_WAIT_V(8); PG8_WAIT_L(0); PG8_BAR; PG8_MMA(0, 0, At, B0); PG8_MMA(0, 1, At, B1); PG8_BAR; PG8_SCHED;
            PG8_LDA(At, 0, 1); PG8_STAGE(PG8_SB(0, 0), b2, voffB); PG8_STAGE(PG8_SB(0, 1), b2 + hstepB, voffB); PG8_STAGE(PG8_SA(0, 0), a2, o2[0]);
            PG8_WAIT_V(8); PG8_WAIT_L(0); PG8_BAR; PG8_MMA(1, 0, At, B0); PG8_MMA(1, 1, At, B1); PG8_BAR; PG8_SCHED;
            PG8_LDB(B0, 1, 0); PG8_LDB(B1, 1, 1); PG8_SCHED; PG8_LDA(At, 1, 0); PG8_STAGE(PG8_SA(0, 1), a2 + hsA, o2[1]);
            PG8_WAIT_V(8); PG8_WAIT_L(0); PG8_BAR; PG8_MMA(0, 0, At, B0); PG8_MMA(0, 1, At, B1); PG8_BAR; PG8_SCHED;
            PG8_LDA(At, 1, 1); PG8_STAGE(PG8_SB(1, 0), b3, voffB); PG8_STAGE(PG8_SB(1, 1), b3 + hstepB, voffB); PG8_STAGE(PG8_SA(1, 0), a3, o2[0]);
            PG8_WAIT_V(8); PG8_WAIT_L(0); PG8_BAR; PG8_MMA(1, 0, At, B0); PG8_MMA(1, 1, At, B1); PG8_BAR; PG8_SCHED;
        }
        if (wr == 0) PG8_BAR;
        { int t2 = tid; asm volatile("" : "+v"(t2)); const int l2 = t2 & 63; E(acc, cur, wr, wc, l2 & 15, l2 >> 4); }
        if (!has_next) break;
#pragma unroll
        for (int a = 0; a < 2; ++a)
#pragma unroll
            for (int b = 0; b < 2; ++b)
#pragma unroll
                for (int m = 0; m < 4; ++m)
#pragma unroll
                    for (int n = 0; n < 2; ++n) acc[a][b][m][n] = (f32x4){zf, zf, zf, zf};
        cur = nxt; cA = nA; cB = nB; ++ui;
#pragma unroll
        for (int _h = 0; _h < 2; ++_h)
#pragma unroll
            for (int _i = 0; _i < 2; ++_i) oC[_h][_i] = o2[_h][_i];
        if (wr == 1) PG8_BAR;
    }
    PG8_WAIT_V(0);
    PG8_BAR;
#undef PG8_LOADOFF
#undef PG8_LD16
#undef PG8_SA
#undef PG8_SB
#undef PG8_STAGE
#undef PG8_LDA
#undef PG8_LDB
#undef PG8_MMA
#undef PG8_WAIT_V
#undef PG8_WAIT_L
#undef PG8_BAR
#undef PG8_SCHED
}

struct EpiBf16Bias {
    static constexpr bool PERM = true;
    bf16_t* O; int ldc; const float* bias;
    __device__ __forceinline__ void operator()(const f32x4 (&acc)[2][2][4][2], const Unit& u, int wr, int wc, int fr, int fq) const {
        const int row0 = u.pm * BM + wr * 64 + fr, col0 = u.pn * BM + wc * 32 + 8 * fq;
        f32x4 bv[2][2];
#pragma unroll
        for (int bj = 0; bj < 2; ++bj)
#pragma unroll
            for (int n = 0; n < 2; ++n) bv[bj][n] = *(const f32x4*)(bias + col0 + bj * HALF + 4 * n);
#pragma unroll
        for (int ai = 0; ai < 2; ++ai)
#pragma unroll
            for (int m = 0; m < 4; ++m) { bf16_t* rowp = O + (size_t)(row0 + ai * HALF + m * 16) * ldc + col0;
#pragma unroll
                for (int bj = 0; bj < 2; ++bj) { const f32x4 v0 = acc[ai][bj][m][0] + bv[bj][0], v1 = acc[ai][bj][m][1] + bv[bj][1];
                    u32x4 w; w.x = pk2(v0[0], v0[1]); w.y = pk2(v0[2], v0[3]); w.z = pk2(v1[0], v1[1]); w.w = pk2(v1[2], v1[3]);
                    *(u32x4*)(rowp + bj * HALF) = w; } }
    }
};
struct EpiResBf16 {
    static constexpr bool PERM = true;
    bf16_t* O; const bf16_t* res; const float* bias;
    __device__ __forceinline__ void operator()(const f32x4 (&acc)[2][2][4][2], const Unit& u, int wr, int wc, int fr, int fq) const {
        const int row0 = u.pm * BM + wr * 64 + fr, col0 = u.pn * BM + wc * 32 + 8 * fq;
        f32x4 bv[2][2];
#pragma unroll
        for (int bj = 0; bj < 2; ++bj)
#pragma unroll
            for (int n = 0; n < 2; ++n) bv[bj][n] = *(const f32x4*)(bias + col0 + bj * HALF + 4 * n);
#pragma unroll
        for (int am = 0; am < 4; ++am) { const int ai = am >> 1;
            u32x4 rv[2][2];
#pragma unroll
            for (int mm = 0; mm < 2; ++mm)
#pragma unroll
                for (int bj = 0; bj < 2; ++bj) rv[mm][bj] = *(const u32x4*)(res + (size_t)(row0 + ai * HALF + ((am & 1) * 2 + mm) * 16) * DM + col0 + bj * HALF);
#pragma unroll
            for (int mm = 0; mm < 2; ++mm) { const int m = (am & 1) * 2 + mm; bf16_t* rowp = O + (size_t)(row0 + ai * HALF + m * 16) * DM + col0;
#pragma unroll
                for (int bj = 0; bj < 2; ++bj) { const u32x4 r = rv[mm][bj]; f32x4 v0 = acc[ai][bj][m][0] + bv[bj][0], v1 = acc[ai][bj][m][1] + bv[bj][1];
                    v0[0] += DN_ALPHA * bflo(r.x); v0[1] += DN_ALPHA * bfhi(r.x); v0[2] += DN_ALPHA * bflo(r.y); v0[3] += DN_ALPHA * bfhi(r.y);
                    v1[0] += DN_ALPHA * bflo(r.z); v1[1] += DN_ALPHA * bfhi(r.z); v1[2] += DN_ALPHA * bflo(r.w); v1[3] += DN_ALPHA * bfhi(r.w);
                    u32x4 w; w.x = pk2(v0[0], v0[1]); w.y = pk2(v0[2], v0[3]); w.z = pk2(v1[0], v1[1]); w.w = pk2(v1[2], v1[3]);
                    *(u32x4*)(rowp + bj * HALF) = w; } } }
    }
};
struct EpiSwiGLU {
    static constexpr bool PERM = false;
    unsigned char* ACT; const float* bgu;
    __device__ __forceinline__ void operator()(const f32x4 (&acc)[2][2][4][2], const Unit& u, int wr, int wc, int fr, int fq) const {
        const int row0 = u.pm * BM + wr * 64 + fr, j0 = u.pn * 128 + wc * 16 + 4 * fq;
        const float* be = bgu + (size_t)u.e * 2048;
        f32x4 bg[2], bu[2];
#pragma unroll
        for (int bj = 0; bj < 2; ++bj) { bg[bj] = *(const f32x4*)(be + j0 + bj * 64); bu[bj] = *(const f32x4*)(be + 1024 + j0 + bj * 64); }
#pragma unroll
        for (int ai = 0; ai < 2; ++ai)
#pragma unroll
            for (int m = 0; m < 4; ++m) { unsigned char* rowp = ACT + (size_t)(row0 + ai * HALF + m * 16) * 1024 + j0;
#pragma unroll
                for (int bj = 0; bj < 2; ++bj) { const f32x4 g4 = acc[ai][bj][m][0] * (1.0f / W8_SCALE) + bg[bj], u4 = acc[ai][bj][m][1] * (1.0f / W8_SCALE) + bu[bj]; float o[4];
#pragma unroll
                    for (int i = 0; i < 4; ++i) { const float g = fminf(g4[i], 7.0f), up = __builtin_amdgcn_fmed3f(u4[i], -7.0f, 7.0f);
                        const float rs = __builtin_amdgcn_rcpf(1.0f + __builtin_amdgcn_exp2f(g * -2.45546696f)); o[i] = __builtin_fmaf(up, ACT8_SCALE, ACT8_SCALE) * (g * rs); }
                    *(unsigned*)(rowp + bj * 64) = pk4_fp8(o[0], o[1], o[2], o[3]); } }
    }
};
struct EpiDown {
    static constexpr bool PERM = true;
    bf16_t* Y; const float* bdn; const int* rowslot; const float* slotg; LAS const int* mpre; const int* cnt;
    __device__ __forceinline__ void operator()(const f32x4 (&acc)[2][2][4][2], const Unit& u, int wr, int wc, int fr, int fq) const {
        const int rl0 = wr * 64 + fr, col0 = u.pn * BM + wc * 32 + 8 * fq;
        const int nvalid = cnt[u.e] - (u.pm - mpre[u.e]) * BM;
        const float* be = bdn + (size_t)u.e * 1024;
        f32x4 bv[2][2];
#pragma unroll
        for (int bj = 0; bj < 2; ++bj)
#pragma unroll
            for (int n = 0; n < 2; ++n) bv[bj][n] = *(const f32x4*)(be + col0 + bj * HALF + 4 * n);
        int slots[2][4]; float gts[2][4];
#pragma unroll
        for (int ai = 0; ai < 2; ++ai)
#pragma unroll
            for (int m = 0; m < 4; ++m) { slots[ai][m] = rowslot[u.pm * BM + rl0 + ai * HALF + m * 16]; gts[ai][m] = slotg[u.pm * BM + rl0 + ai * HALF + m * 16]; }
#pragma unroll
        for (int ai = 0; ai < 2; ++ai)
#pragma unroll
            for (int m = 0; m < 4; ++m) { const int rl = rl0 + ai * HALF + m * 16;
                if (rl < nvalid) { const int slot = slots[ai][m]; const float g = gts[ai][m]; bf16_t* rowp = Y + (size_t)slot * 1024 + col0;
#pragma unroll
                    for (int bj = 0; bj < 2; ++bj) { const f32x4 v0 = (acc[ai][bj][m][0] * (1.0f / (W8_SCALE * ACT8_SCALE)) + bv[bj][0]) * g, v1 = (acc[ai][bj][m][1] * (1.0f / (W8_SCALE * ACT8_SCALE)) + bv[bj][1]) * g;
                        u32x4 w; w.x = pk2(v0[0], v0[1]); w.y = pk2(v0[2], v0[3]); w.z = pk2(v1[0], v1[1]); w.w = pk2(v1[2], v1[3]);
                        *(u32x4*)(rowp + bj * HALF) = w; } } }
    }
};
}

#define XB_TMO      128
#define XB_XCNT(j)  (256  + 64 * (j))
#define XB_XSUB(j)  (1280 + 64 * (j))
#define XB_XGEN(j)  (2304 + 64 * (j))
#define XB_TOP      3328
#define XB_TOPGEN   3392
#define XCD_BAR_WORDS 3456
#define XB_SPIN_CAP (1u << 18)
__device__ __forceinline__ unsigned xb_ld(unsigned* p)              { return __hip_atomic_load(p, __ATOMIC_RELAXED, __HIP_MEMORY_SCOPE_AGENT); }
__device__ __forceinline__ unsigned xb_add(unsigned* p, unsigned v) { return __hip_atomic_fetch_add(p, v, __ATOMIC_RELAXED, __HIP_MEMORY_SCOPE_AGENT); }
__device__ __forceinline__ unsigned xb_xcc_id() { return (unsigned)__builtin_amdgcn_s_getreg((3 << 11) | 20) & 0xFu; }
#define XB_SPIN(cond, bar) do { unsigned _sp = 0; while (cond) { __builtin_amdgcn_s_sleep(1); \
    if ((++_sp & 255u) == 0u) { if (xb_ld(&(bar)[XB_TMO])) break; if (_sp > XB_SPIN_CAP) { atomicAdd(&(bar)[XB_TMO], 1u); break; } } } } while (0)
struct XcdBarrier { unsigned* bar; unsigned x; volatile LAS unsigned* st; };
__device__ __forceinline__ XcdBarrier xcd_barrier_post(unsigned* bar, volatile LAS unsigned* st) {
    XcdBarrier b; b.bar = bar; b.x = xb_xcc_id(); b.st = st;
    if (threadIdx.x == 0) (void)xb_add(&bar[XB_XCNT(b.x)], 1u);
    return b;
}
__device__ __forceinline__ void xcd_barrier_complete(unsigned* bar, unsigned x, unsigned& nloc, unsigned& nx) {
    const unsigned G = gridDim.x * gridDim.y * gridDim.z;
    unsigned sum, cnt, mine, sp = 0u;
    for (;;) {
        sum = 0u; cnt = 0u; mine = 0u;
#pragma unroll
        for (unsigned j = 0; j < 16; ++j) { const unsigned c = xb_ld(&bar[XB_XCNT(j)]); sum += c; cnt += (c > 0u) ? 1u : 0u; mine = (j == x) ? c : mine; }
        if (sum == G) break;
        __builtin_amdgcn_s_sleep(1);
        if ((++sp & 255u) == 0u) { if (xb_ld(&bar[XB_TMO])) break; if (sp > XB_SPIN_CAP) { atomicAdd(&bar[XB_TMO], 1u); break; } }
    }
    nloc = mine > 0u ? mine : 1u; nx = cnt > 0u ? cnt : 1u;
}
__device__ __forceinline__ void xcd_barrier(const XcdBarrier& b, const int tid0) {
    asm volatile("s_waitcnt vmcnt(0)" ::: "memory");
    __syncthreads();
    if (tid0 == 0) {
        unsigned* bar = b.bar;
        __builtin_amdgcn_s_waitcnt(0);
        unsigned nloc = b.st[0], nx = b.st[1];
        if (nloc == 0u) { xcd_barrier_complete(bar, b.x, nloc, nx); b.st[0] = nloc; b.st[1] = nx; }
        const unsigned old = xb_add(&bar[XB_XSUB(b.x)], 1u);
        const unsigned gen = old / nloc;
        if (old + 1u == (gen + 1u) * nloc) {
            __builtin_amdgcn_fence(__ATOMIC_RELEASE, "agent");
            asm volatile("s_waitcnt vmcnt(0)" ::: "memory");
            const unsigned og = xb_add(&bar[XB_TOP], 1u);
            const unsigned tg = og / nx;
            if (og + 1u == (tg + 1u) * nx) xb_add(&bar[XB_TOPGEN], 1u);
            else XB_SPIN(xb_ld(&bar[XB_TOPGEN]) == tg, bar);
            __builtin_amdgcn_fence(__ATOMIC_ACQUIRE, "agent");
            xb_add(&bar[XB_XGEN(b.x)], 1u);
            asm volatile("s_waitcnt vmcnt(0)" ::: "memory");
        } else {
            XB_SPIN(xb_ld(&bar[XB_XGEN(b.x)]) == gen, bar);
            __builtin_amdgcn_fence(__ATOMIC_ACQUIRE, "agent");
            asm volatile("s_waitcnt vmcnt(0)" ::: "memory");
        }
    }
    __syncthreads();
}

struct Args { const float* in[18]; float* out; unsigned char* ws; int ph_lo, ph_hi, coop, rep, nrep, pad; };

struct P0Item { const float* W; bf16_t* WT; int N, mode, k0, n0; };
__device__ __forceinline__ P0Item p0_decode(const Args& a, int it) {
    constexpr int IN_IT = 16 * 46, OUT_IT = 256, GU_IT = 512, DN_IT = 256, LAYER_IT = IN_IT + OUT_IT + 32 * GU_IT + 32 * DN_IT;
    unsigned char* ws = a.ws; P0Item p; p.mode = 0;
    const int l = it / LAYER_IT; int r = it % LAYER_IT;
    if (r < IN_IT) { p.W = a.in[1] + (size_t)l * 1024 * INW; p.N = INW; p.WT = (bf16_t*)(ws + WS_WIN) + (size_t)l * INWP * 1024; }
    else if ((r -= IN_IT) < OUT_IT) { p.W = a.in[6] + (size_t)l * 1024 * 1024; p.N = 1024; p.WT = (bf16_t*)(ws + WS_WOUT) + (size_t)l * 1024 * 1024; }
    else if ((r -= OUT_IT) < 32 * GU_IT) { const int e = r / GU_IT; r %= GU_IT; p.W = a.in[12] + (size_t)(l * 32 + e) * 1024 * 2048; p.N = 2048; p.WT = (bf16_t*)(ws + WS_WGU + (size_t)(l * 32 + e) * 2048 * 1024); p.mode = 1; }
    else { r -= 32 * GU_IT; const int e = r / DN_IT; r %= DN_IT; p.W = a.in[14] + (size_t)(l * 32 + e) * 1024 * 1024; p.N = 1024; p.WT = (bf16_t*)(ws + WS_WDN + (size_t)(l * 32 + e) * 1024 * 1024); p.mode = 2; }
    const int nblk = p.N / 64; p.k0 = (r / nblk) * 64; p.n0 = (r % nblk) * 64;
    return p;
}
__device__ __forceinline__ void phase_prologue(const Args& a, LAS unsigned char* lds, const int tid) {
    const int lane = tid & 63, wave = __builtin_amdgcn_readfirstlane(tid >> 6), G = gridDim.x;
    const int gw = blockIdx.x * 8 + wave, NGW = G * 8; const int gt = blockIdx.x * 512 + tid, NGT = G * 512;
    unsigned char* ws = a.ws;
    if (gt < 64) ((int*)(ws + WS_CTL))[gt] = 0;
    if (gt < 24) ((float*)(ws + WS_CTL + 1024))[gt] = 0.f;
    for (int i = gt; i < 2 * INWP; i += NGT) { const int l = i / INWP, c = i % INWP; ((float*)(ws + WS_BPAD))[i] = c < INW ? a.in[2][l * INW + c] : 0.f; }
    { unsigned zu = 0u; asm volatile("" : "+v"(zu));
      for (int i = gt; i < 2 * 16 * 128 * 8; i += NGT) { const int l = i / (16 * 128 * 8), kt = (i / (128 * 8)) & 15, r = 128 + ((i >> 3) & 127), pc = i & 7;
        *(u32x4*)(ws + WS_WIN + (size_t)l * INWP * 2048 + (size_t)11 * (256 * 2048) + (size_t)kt * 32768 + (size_t)r * 128 + pc * 16) = (u32x4){zu, zu, zu, zu}; } }
    for (int i = gt; i < 2 * 4 * 4096; i += NGT) { const int lg = i >> 12, d = (i >> 6) & 63, c = i & 63; const float v = a.in[3][(size_t)lg * 4096 + c * 64 + d]; ((bf16_t*)(ws + WS_POOLW))[i] = (bf16_t)(pk2(v, v) & 0xffff); }
    for (int i = gt; i < 16384 * 32; i += NGT) { const int pos = i >> 5, f = i & 31;
        double invd = 1.0; for (int j = 0; j < f; ++j) invd *= 0.7498942093324559;
        const float inv = (float)invd;
        const float ang = (float)pos * inv;
        const double rev = (double)ang * 0.15915494309189535; const float fr = (float)(rev - rint(rev));
        ((float*)(ws + WS_ROT))[i] = __builtin_amdgcn_cosf(fr); ((float*)(ws + WS_ROT))[16384 * 32 + i] = __builtin_amdgcn_sinf(fr); }
    { const f32x4* x4 = (const f32x4*)a.in[0]; u32x2* o = (u32x2*)(ws + WS_XB);
      for (int i = gt; i < NTOK * 1024 / 4; i += NGT) { const f32x4 v = x4[i]; u32x2 w; w.x = pk2(v[0], v[1]); w.y = pk2(v[2], v[3]); o[i] = w; } }
    LAS float* scr = (LAS float*)(lds + wave * 16640);
    constexpr int NIT = 2 * (16 * 46 + 256 + 32 * 512 + 32 * 256);
    float v[64];
    int it = gw;
    if (it < NIT) { const P0Item p = p0_decode(a, it); const float* src = p.W + (size_t)p.k0 * p.N + p.n0 + lane;
#pragma unroll
        for (int i = 0; i < 64; ++i) v[i] = src[(size_t)i * p.N]; }
    for (; it < NIT; it += NGW) {
        const P0Item p = p0_decode(a, it);
#pragma unroll
        for (int i = 0; i < 64; ++i) scr[i * 65 + lane] = v[i];
        lds_fence();
        if (it + NGW < NIT) { const P0Item pn = p0_decode(a, it + NGW); const float* src = pn.W + (size_t)pn.k0 * pn.N + pn.n0 + lane;
#pragma unroll
            for (int i = 0; i < 64; ++i) v[i] = src[(size_t)i * pn.N]; }
        const int c = lane & 7;
#pragma unroll
        for (int j = 0; j < 8; ++j) { const int nl = (lane >> 3) + 8 * j; const LAS float* sp = scr + (8 * c) * 65 + nl;
            const int n = p.n0 + nl; int dest = n;
            if (p.mode == 1) { const int jj = n & 1023; dest = ((jj >> 4) << 5) + (jj & 15) + ((n >> 10) << 4); }
            const size_t tl = (size_t)(dest >> 8), rr = (size_t)(dest & 255);
            if (p.mode == 0) { u32x4 o; o.x = pk2(sp[0], sp[65]); o.y = pk2(sp[2 * 65], sp[3 * 65]); o.z = pk2(sp[4 * 65], sp[5 * 65]); o.w = pk2(sp[6 * 65], sp[7 * 65]);
                *(u32x4*)((unsigned char*)p.WT + tl * (256 * 2048) + (size_t)(p.k0 >> 6) * 32768 + rr * 128 + 16 * c) = o; }
            else { u32x2 o; o.x = pk4_fp8(sp[0] * W8_SCALE, sp[65] * W8_SCALE, sp[2 * 65] * W8_SCALE, sp[3 * 65] * W8_SCALE); o.y = pk4_fp8(sp[4 * 65] * W8_SCALE, sp[5 * 65] * W8_SCALE, sp[6 * 65] * W8_SCALE, sp[7 * 65] * W8_SCALE);
                *(u32x2*)((unsigned char*)p.WT + tl * (256 * 1024) + (size_t)(p.k0 >> 7) * 32768 + rr * 128 + (p.k0 & 127) + 8 * c) = o; } }
        lds_fence();
    }
}

constexpr int TLD = 72;
constexpr int TLDA = 68;
template <bool SCALE>
__device__ __forceinline__ void load_tile_T(const bf16_t* src, LAS bf16_t* T, int lane, float sc0, float scmul) {
    const int cr = lane >> 3, dc = lane & 7;
    u32x4 v[8];
#pragma unroll
    for (int i = 0; i < 8; ++i) v[i] = *(const u32x4*)(src + (size_t)(cr + 8 * i) * INWP + 8 * dc);
#pragma unroll
    for (int i = 0; i < 8; ++i) { const int row = cr + 8 * i; u32x4 w = v[i];
        if (SCALE) { const float s = sc0 * __builtin_amdgcn_exp2f(scmul * (float)row);
            w.x = pk2(bflo(w.x) * s, bfhi(w.x) * s); w.y = pk2(bflo(w.y) * s, bfhi(w.y) * s); w.z = pk2(bflo(w.z) * s, bfhi(w.z) * s); w.w = pk2(bflo(w.w) * s, bfhi(w.w) * s); }
        LAS bf16_t* t = T + (8 * dc) * TLD + row;
        t[0 * TLD] = (bf16_t)(w.x & 0xffff); t[1 * TLD] = (bf16_t)(w.x >> 16); t[2 * TLD] = (bf16_t)(w.y & 0xffff); t[3 * TLD] = (bf16_t)(w.y >> 16);
        t[4 * TLD] = (bf16_t)(w.z & 0xffff); t[5 * TLD] = (bf16_t)(w.z >> 16); t[6 * TLD] = (bf16_t)(w.w & 0xffff); t[7 * TLD] = (bf16_t)(w.w >> 16); }
}
__device__ __forceinline__ float log2_gamma(int h) { return log2f(1.0f - exp2f(-5.0f - (float)h)); }

__device__ __forceinline__ void rot8(u32x4 x1, u32x4 x2, const float* cs, const float* sn, float sc, u32x4& o1, u32x4& o2) {
    const f32x4 c0 = *(const f32x4*)cs, c1 = *(const f32x4*)(cs + 4), s0 = *(const f32x4*)sn, s1 = *(const f32x4*)(sn + 4);
    float a[8], b[8], c[8], s[8];
    a[0] = bflo(x1.x); a[1] = bfhi(x1.x); a[2] = bflo(x1.y); a[3] = bfhi(x1.y); a[4] = bflo(x1.z); a[5] = bfhi(x1.z); a[6] = bflo(x1.w); a[7] = bfhi(x1.w);
    b[0] = bflo(x2.x); b[1] = bfhi(x2.x); b[2] = bflo(x2.y); b[3] = bfhi(x2.y); b[4] = bflo(x2.z); b[5] = bfhi(x2.z); b[6] = bflo(x2.w); b[7] = bfhi(x2.w);
#pragma unroll
    for (int i = 0; i < 4; ++i) { c[i] = c0[i]; c[4 + i] = c1[i]; s[i] = s0[i]; s[4 + i] = s1[i]; }
    float p[8], q[8];
#pragma unroll
    for (int i = 0; i < 8; ++i) { p[i] = (a[i] * c[i] - b[i] * s[i]) * sc; q[i] = (a[i] * s[i] + b[i] * c[i]) * sc; }
    o1.x = pk2(p[0], p[1]); o1.y = pk2(p[2], p[3]); o1.z = pk2(p[4], p[5]); o1.w = pk2(p[6], p[7]);
    o2.x = pk2(q[0], q[1]); o2.y = pk2(q[2], q[3]); o2.z = pk2(q[4], q[5]); o2.w = pk2(q[6], q[7]);
}

__device__ __forceinline__ void pool_item(const bf16_t* hbuf, const bf16_t* pwT, const float* pscale, bf16_t* mixed, int item, int lane) {
    const int k = item >> 11, gwi = item & 2047, g = (gwi + k) & 3, tile = (gwi >> 2) * 4 + k, t0 = tile * 16, w = 2 << g;
    const int r = lane & 15, q = lane >> 4, t = t0 + r, ts = t % SEQ;
    const bf16_t* up = hbuf + (size_t)t * INWP + g * 64 + 8 * q;
    bf16x8 pf[2];
#pragma unroll
    for (int ks = 0; ks < 2; ++ks) { float s[8], u0[8];
#pragma unroll
        for (int e = 0; e < 8; ++e) s[e] = 0.f;
        for (int i = 0; i < w; ++i) { if (ts - i >= 0) { const u32x4 v = *(const u32x4*)(up - (size_t)i * INWP + 32 * ks);
            const float f[8] = {bflo(v.x), bfhi(v.x), bflo(v.y), bfhi(v.y), bflo(v.z), bfhi(v.z), bflo(v.w), bfhi(v.w)};
#pragma unroll
            for (int e = 0; e < 8; ++e) { s[e] += f[e]; if (i == 0) u0[e] = f[e]; } } }
        const float cnt = (float)min(ts + 1, w); float o[8];
#pragma unroll
        for (int e = 0; e < 8; ++e) o[e] = s[e] / cnt - u0[e];
        pf[ks] = as_bf16x8((u32x4){pk2(o[0], o[1]), pk2(o[2], o[3]), pk2(o[4], o[5]), pk2(o[6], o[7])}); }
#pragma unroll
    for (int dt = 0; dt < 4; ++dt) { f32x4 acc = {0.f, 0.f, 0.f, 0.f};
#pragma unroll
        for (int ks = 0; ks < 2; ++ks) { const bf16x8 wf = as_bf16x8(*(const u32x4*)(pwT + (g * 64 + 16 * dt + r) * 64 + 32 * ks + 8 * q)); acc = __builtin_amdgcn_mfma_f32_16x16x32_bf16(wf, pf[ks], acc, 0, 0, 0); }
        const int d = g * 64 + 16 * dt + 4 * q; const f32x4 sc = *(const f32x4*)(pscale + d);
        u32x2 o; o.x = pk2(acc[0] * sc[0], acc[1] * sc[1]); o.y = pk2(acc[2] * sc[2], acc[3] * sc[3]);
        *(u32x2*)(mixed + (size_t)t * 1024 + d) = o; }
}

__device__ __forceinline__ void retkv_item(const bf16_t* hbuf, const float* rot, float* kvbuf, LAS bf16_t* wl, int item, int lane) {
    const int bh = item / NCHUNK, n = item % NCHUNK, b = bh / 6, h = bh % 6; const size_t t0 = (size_t)b * SEQ + (size_t)n * 64;
    LAS bf16_t* kT = wl; LAS bf16_t* vT = wl + 64 * TLD;
    const float l2g = log2_gamma(h);
    load_tile_T<true>(hbuf + t0 * INWP + C_RV + h * 64, vT, lane, exp2f(l2g * 63.f), -l2g);
    { const int cr = lane >> 3, dc = lane & 7, fc = dc & 3;
#pragma unroll
      for (int i = 0; i < 8; ++i) { const int row = cr + 8 * i; const bf16_t* kp = hbuf + (t0 + row) * INWP + C_RK + h * 64;
          const u32x4 x1 = *(const u32x4*)(kp + 8 * fc), x2 = *(const u32x4*)(kp + 32 + 8 * fc);
          const int pos = n * 64 + row; u32x4 o1, o2;
          rot8(x1, x2, rot + (size_t)pos * 32 + 8 * fc, rot + 16384 * 32 + (size_t)pos * 32 + 8 * fc, 0.125f, o1, o2);
          const u32x4 w = dc < 4 ? o1 : o2;
          LAS bf16_t* t = kT + (8 * dc) * TLD + row;
          t[0 * TLD] = (bf16_t)(w.x & 0xffff); t[1 * TLD] = (bf16_t)(w.x >> 16); t[2 * TLD] = (bf16_t)(w.y & 0xffff); t[3 * TLD] = (bf16_t)(w.y >> 16);
          t[4 * TLD] = (bf16_t)(w.z & 0xffff); t[5 * TLD] = (bf16_t)(w.z >> 16); t[6 * TLD] = (bf16_t)(w.w & 0xffff); t[7 * TLD] = (bf16_t)(w.w >> 16); } }
    lds_fence();
    const int r = lane & 15, q = lane >> 4;
    float* outp = kvbuf + (size_t)item * 4096;
#pragma unroll
    for (int et = 0; et < 4; ++et) {
        bf16x8 vf[2];
#pragma unroll
        for (int ks = 0; ks < 2; ++ks) vf[ks] = *(const LAS bf16x8*)(vT + (16 * et + r) * TLD + 32 * ks + 8 * q);
#pragma unroll
        for (int dt = 0; dt < 4; ++dt) { f32x4 acc = {0.f, 0.f, 0.f, 0.f};
#pragma unroll
            for (int ks = 0; ks < 2; ++ks) { const bf16x8 kf = *(const LAS bf16x8*)(kT + (16 * dt + r) * TLD + 32 * ks + 8 * q);
                acc = __builtin_amdgcn_mfma_f32_16x16x32_bf16(kf, vf[ks], acc, 0, 0, 0); }
            *(f32x4*)(outp + (16 * et + r) * 64 + 16 * dt + 4 * q) = acc; } }
    lds_fence();
}
__device__ __forceinline__ void knorm_item(const bf16_t* hbuf, float* kmax2, int item, int lane) {
    const int bh = item / NCHUNK, n = item % NCHUNK, b = bh / 6, h = bh % 6; const size_t t0 = (size_t)b * SEQ + (size_t)n * 64;
    const int cr = lane >> 3, dc = lane & 7; float mx = 0.f;
#pragma unroll
    for (int i = 0; i < 8; ++i) { const u32x4 v = *(const u32x4*)(hbuf + (t0 + cr + 8 * i) * INWP + C_SBK + h * 64 + 8 * dc);
        float s = bflo(v.x) * bflo(v.x) + bfhi(v.x) * bfhi(v.x) + bflo(v.y) * bflo(v.y) + bfhi(v.y) * bfhi(v.y) + bflo(v.z) * bflo(v.z) + bfhi(v.z) * bfhi(v.z) + bflo(v.w) * bflo(v.w) + bfhi(v.w) * bfhi(v.w);
        s += sx(s, 1, lane); s += sx(s, 2, lane); s += sx(s, 4, lane); mx = fmaxf(mx, s); }
    mx = fmaxf(mx, sx(mx, 8, lane)); mx = fmaxf(mx, sx(mx, 16, lane)); mx = fmaxf(mx, sx(mx, 32, lane));
    if (lane == 0) atomicMax((unsigned*)kmax2 + bh, __float_as_uint(mx));
}

__device__ __forceinline__ bf16x8 pack_tiles(const f32x4& t0, const f32x4& t1) { u32x4 w; w.x = pk2(t0[0], t0[1]); w.y = pk2(t0[2], t0[3]); w.z = pk2(t1[0], t1[1]); w.w = pk2(t1[2], t1[3]); return as_bf16x8(w); }
template <int P = TLD>
__device__ __forceinline__ bf16x8 vt_frag(const LAS bf16_t* vT, int et, int mb, int r, int q) {
    const LAS bf16_t* p = vT + (16 * et + r) * P + 32 * mb + 4 * q; const u32x2 a = *(const LAS u32x2*)p, b = *(const LAS u32x2*)(p + 16);
    return as_bf16x8((u32x4){a.x, a.y, b.x, b.y});
}

__device__ __forceinline__ void sb_item(const bf16_t* hbuf, const float* kmax2, bf16_t* mixed, LAS bf16_t* vT, int item, int lane) {
    const int bh = item >> 10, qt = item & 1023, b = bh / 6, h = bh % 6, tq0 = qt * 16; const size_t row0 = (size_t)b * SEQ + tq0;
    const int r = lane & 15, q = lane >> 4;
    bf16x8 qf[2]; float bound, carry = 0.f;
    const float km2 = kmax2[bh];
    { float s = 0.f;
#pragma unroll
      for (int ks = 0; ks < 2; ++ks) { const u32x4 v = *(const u32x4*)(hbuf + (row0 + r) * INWP + C_SBQ + h * 64 + 32 * ks + 8 * q); qf[ks] = as_bf16x8(v);
          s += bflo(v.x) * bflo(v.x) + bfhi(v.x) * bfhi(v.x) + bflo(v.y) * bflo(v.y) + bfhi(v.y) * bfhi(v.y) + bflo(v.z) * bflo(v.z) + bfhi(v.z) * bfhi(v.z) + bflo(v.w) * bflo(v.w) + bfhi(v.w) * bfhi(v.w); }
      s += sx(s, 16, lane); s += sx(s, 32, lane);
      bound = sqrtf(s * km2) * 0.125f * 1.01f + 0.05f; }
    const int qpos = tq0 + r;
    f32x4 O[4];
#pragma unroll
    for (int et = 0; et < 4; ++et) O[et] = (f32x4){0.f, 0.f, 0.f, 0.f};
    const int cr = lane >> 3, dc = lane & 7;
    const bf16_t* seqp = hbuf + (size_t)b * SEQ * INWP + h * 64;
    u32x4 vreg[8], kreg[8];
    { const int k0 = tq0 + 16 - 64;
#pragma unroll
      for (int i = 0; i < 8; ++i) vreg[i] = *(const u32x4*)(seqp + (size_t)max(k0 + cr + 8 * i, 0) * INWP + C_SBV + 8 * dc);
#pragma unroll
      for (int i = 0; i < 8; ++i) kreg[i] = *(const u32x4*)(seqp + (size_t)max(k0 + 16 * (i >> 1) + r, 0) * INWP + C_SBK + 32 * (i & 1) + 8 * q); }
    for (int k0 = tq0 + 16 - 64; k0 > -64; k0 -= 64) {
#pragma unroll
        for (int i = 0; i < 8; ++i) { const int row = cr + 8 * i; const u32x4 w = vreg[i]; LAS bf16_t* t = vT + (8 * dc) * TLDA + row;
            t[0 * TLDA] = (bf16_t)(w.x & 0xffff); t[1 * TLDA] = (bf16_t)(w.x >> 16); t[2 * TLDA] = (bf16_t)(w.y & 0xffff); t[3 * TLDA] = (bf16_t)(w.y >> 16);
            t[4 * TLDA] = (bf16_t)(w.z & 0xffff); t[5 * TLDA] = (bf16_t)(w.z >> 16); t[6 * TLDA] = (bf16_t)(w.w & 0xffff); t[7 * TLDA] = (bf16_t)(w.w >> 16); }
        f32x4 z[4], lk[4];
#pragma unroll
        for (int mt = 0; mt < 4; ++mt) { f32x4 acc = {0.f, 0.f, 0.f, 0.f};
#pragma unroll
            for (int ks = 0; ks < 2; ++ks) acc = __builtin_amdgcn_mfma_f32_16x16x32_bf16(as_bf16x8(kreg[2 * mt + ks]), qf[ks], acc, 0, 0, 0);
            z[mt] = acc; }
        if (k0 > 0) { const int kn0 = k0 - 64;
#pragma unroll
            for (int i = 0; i < 8; ++i) vreg[i] = *(const u32x4*)(seqp + (size_t)max(kn0 + cr + 8 * i, 0) * INWP + C_SBV + 8 * dc);
#pragma unroll
            for (int i = 0; i < 8; ++i) kreg[i] = *(const u32x4*)(seqp + (size_t)max(kn0 + 16 * (i >> 1) + r, 0) * INWP + C_SBK + 32 * (i & 1) + 8 * q); }
#pragma unroll
        for (int mt = 0; mt < 4; ++mt) {
            z[mt] = z[mt] * 0.125f;
#pragma unroll
            for (int j = 0; j < 4; ++j) { const int kp = k0 + 16 * mt + 4 * q + j; const bool valid = (kp < qpos) && (kp >= 0); const float zz = z[mt][j];
                lk[mt][j] = valid ? -(fmaxf(zz, 0.f) + __logf(1.0f + __expf(-fabsf(zz)))) : 0.f; } }
        bf16x8 lh[2], ll[2];
#pragma unroll
        for (int mb = 0; mb < 2; ++mb) { lh[mb] = pack_tiles(lk[2 * mb], lk[2 * mb + 1]);
            const u32x4 hw = __builtin_bit_cast(u32x4, lh[mb]); f32x4 d0, d1;
            d0[0] = lk[2 * mb][0] - bflo(hw.x); d0[1] = lk[2 * mb][1] - bfhi(hw.x); d0[2] = lk[2 * mb][2] - bflo(hw.y); d0[3] = lk[2 * mb][3] - bfhi(hw.y);
            d1[0] = lk[2 * mb + 1][0] - bflo(hw.z); d1[1] = lk[2 * mb + 1][1] - bfhi(hw.z); d1[2] = lk[2 * mb + 1][2] - bflo(hw.w); d1[3] = lk[2 * mb + 1][3] - bfhi(hw.w);
            ll[mb] = pack_tiles(d0, d1); }
        f32x4 rs[4];
#pragma unroll
        for (int mt = 0; mt < 4; ++mt) { f32x4 acc = {0.f, 0.f, 0.f, 0.f};
#pragma unroll
            for (int mb = 0; mb < 2; ++mb) {
                const int m = 16 * mt + r; unsigned tw[4];
#pragma unroll
                for (int p = 0; p < 4; ++p) { const int i0 = 2 * p, i1 = 2 * p + 1;
                    const int ma = 32 * mb + (i0 < 4 ? 4 * q + i0 : 16 + 4 * q + i0 - 4), mbb = 32 * mb + (i1 < 4 ? 4 * q + i1 : 16 + 4 * q + i1 - 4);
                    tw[p] = (ma >= m ? 0x3f80u : 0u) | (mbb >= m ? 0x3f800000u : 0u); }
                const bf16x8 tri = as_bf16x8((u32x4){tw[0], tw[1], tw[2], tw[3]});
                acc = __builtin_amdgcn_mfma_f32_16x16x32_bf16(tri, lh[mb], acc, 0, 0, 0);
                acc = __builtin_amdgcn_mfma_f32_16x16x32_bf16(tri, ll[mb], acc, 0, 0, 0); }
            rs[mt] = acc; }
        const float total = sl(rs[0][0], r);
        bf16x8 af[2];
        { f32x4 av[4];
#pragma unroll
          for (int mt = 0; mt < 4; ++mt)
#pragma unroll
              for (int j = 0; j < 4; ++j) { const int kp = k0 + 16 * mt + 4 * q + j; const bool valid = (kp < qpos) && (kp >= 0); av[mt][j] = valid ? __expf(z[mt][j] + rs[mt][j] + carry) : 0.f; }
          af[0] = pack_tiles(av[0], av[1]); af[1] = pack_tiles(av[2], av[3]); }
        lds_fence();
#pragma unroll
        for (int et = 0; et < 4; ++et)
#pragma unroll
            for (int mb = 0; mb < 2; ++mb) O[et] = __builtin_amdgcn_mfma_f32_16x16x32_bf16(vt_frag<TLDA>(vT, et, mb, r, q), af[mb], O[et], 0, 0, 0);
        carry += total;
        lds_fence();
        if (__all(carry + bound < -105.f)) break;
    }
#pragma unroll
    for (int et = 0; et < 4; ++et) { u32x2 w; w.x = pk2(O[et][0], O[et][1]); w.y = pk2(O[et][2], O[et][3]);
        *(u32x2*)(mixed + (row0 + r) * 1024 + M_SB + h * 64 + 16 * et + 4 * q) = w; }
}

__device__ __forceinline__ void retout_item(const bf16_t* hbuf, const float* rot, const float* kvbuf, const float* normg, bf16_t* mixed, LAS bf16_t* vT, int item, int lane) {
    const int bh = item / NCHUNK, n = item % NCHUNK, b = bh / 6, h = bh % 6; const size_t t0 = (size_t)b * SEQ + (size_t)n * 64;
    const int r = lane & 15, q = lane >> 4; const float l2g = log2_gamma(h);
    load_tile_T<false>(hbuf + t0 * INWP + C_RV + h * 64, vT, lane, 0.f, 0.f);
    const float* cs = rot; const float* sn = rot + 16384 * 32;
    bf16x8 kf[4][2]; LAS bf16_t* RT = vT + 64 * TLD;
#pragma unroll
    for (int mt = 0; mt < 4; ++mt) { const int row = 16 * mt + r; const bf16_t* kp = hbuf + (t0 + row) * INWP + C_RK + h * 64 + 8 * q; const int pos = n * 64 + row; u32x4 o1, o2;
        rot8(*(const u32x4*)kp, *(const u32x4*)(kp + 32), cs + (size_t)pos * 32 + 8 * q, sn + (size_t)pos * 32 + 8 * q, 0.125f, o1, o2); kf[mt][0] = as_bf16x8(o1); kf[mt][1] = as_bf16x8(o2); }
    const float* Rp = kvbuf + (size_t)item * 4096;
#pragma unroll
    for (int et = 0; et < 4; ++et)
#pragma unroll
        for (int ks = 0; ks < 2; ++ks) { const float* p = Rp + (16 * et + r) * 64 + 32 * ks + 8 * q; const f32x4 a = *(const f32x4*)p, c = *(const f32x4*)(p + 4);
            *(LAS u32x4*)(RT + (16 * et + r) * TLD + 32 * ks + 8 * q) = (u32x4){pk2(a[0], a[1]), pk2(a[2], a[3]), pk2(c[0], c[1]), pk2(c[2], c[3])}; }
    lds_fence();
#pragma unroll 1
    for (int ct = 0; ct < 4; ++ct) {
        const int c = 16 * ct + r; const bf16_t* qp = hbuf + (t0 + c) * INWP + C_RQ + h * 64 + 8 * q; const int pos = n * 64 + c; u32x4 o1, o2;
        rot8(*(const u32x4*)qp, *(const u32x4*)(qp + 32), cs + (size_t)pos * 32 + 8 * q, sn + (size_t)pos * 32 + 8 * q, 1.0f, o1, o2);
        const bf16x8 q0 = as_bf16x8(o1), q1 = as_bf16x8(o2);
        f32x4 OT[4];
        const float xi = __builtin_amdgcn_exp2f(l2g * (float)(c + 1));
#pragma unroll
        for (int et = 0; et < 4; ++et) { f32x4 acc = {0.f, 0.f, 0.f, 0.f};
            const bf16x8 R0 = *(const LAS bf16x8*)(RT + (16 * et + r) * TLD + 8 * q), R1 = *(const LAS bf16x8*)(RT + (16 * et + r) * TLD + 32 + 8 * q);
            acc = __builtin_amdgcn_mfma_f32_16x16x32_bf16(R0, q0, acc, 0, 0, 0); acc = __builtin_amdgcn_mfma_f32_16x16x32_bf16(R1, q1, acc, 0, 0, 0);
            OT[et] = acc * xi; }
        f32x4 st[4];
#pragma unroll
        for (int mt = 0; mt < 4; ++mt) { f32x4 acc = {0.f, 0.f, 0.f, 0.f};
            acc = __builtin_amdgcn_mfma_f32_16x16x32_bf16(kf[mt][0], q0, acc, 0, 0, 0); acc = __builtin_amdgcn_mfma_f32_16x16x32_bf16(kf[mt][1], q1, acc, 0, 0, 0);
#pragma unroll
            for (int j = 0; j < 4; ++j) { const int m = 16 * mt + 4 * q + j; const int dd = c > m ? c - m : m - c; acc[j] *= __builtin_amdgcn_exp2f(l2g * (float)dd); }
            st[mt] = acc; }
        const bf16x8 p0 = pack_tiles(st[0], st[1]), p1 = pack_tiles(st[2], st[3]);
#pragma unroll
        for (int et = 0; et < 4; ++et) { OT[et] = __builtin_amdgcn_mfma_f32_16x16x32_bf16(vt_frag(vT, et, 0, r, q), p0, OT[et], 0, 0, 0);
            OT[et] = __builtin_amdgcn_mfma_f32_16x16x32_bf16(vt_frag(vT, et, 1, r, q), p1, OT[et], 0, 0, 0); }
        float s = 0.f;
#pragma unroll
        for (int et = 0; et < 4; ++et) s += (OT[et][0] + OT[et][1]) + (OT[et][2] + OT[et][3]);
        s += sx(s, 16, lane); s += sx(s, 32, lane);
        const float mu = s * (1.0f / 64.0f); float v = 0.f;
#pragma unroll
        for (int et = 0; et < 4; ++et)
#pragma unroll
            for (int j = 0; j < 4; ++j) { const float d = OT[et][j] - mu; v += d * d; }
        v += sx(v, 16, lane); v += sx(v, 32, lane);
        const float rstd = rsqrtf(v * (1.0f / 64.0f) + LN_EPS);
#pragma unroll
        for (int et = 0; et < 4; ++et) { const int e = 16 * et + 4 * q;
            const u32x2 gw = *(const u32x2*)(hbuf + (t0 + c) * INWP + C_RG + h * 64 + e); const f32x4 ng = *(const f32x4*)(normg + h * 64 + e);
            float gt[4] = {bflo(gw.x), bfhi(gw.x), bflo(gw.y), bfhi(gw.y)}, o[4];
#pragma unroll
            for (int j = 0; j < 4; ++j) { const float sl = gt[j] * __builtin_amdgcn_rcpf(1.0f + __expf(-gt[j])); o[j] = (OT[et][j] - mu) * rstd * ng[j] * sl; }
            u32x2 w; w.x = pk2(o[0], o[1]); w.y = pk2(o[2], o[3]);
            *(u32x2*)(mixed + (t0 + c) * 1024 + M_RET + h * 64 + e) = w; }
    }
    lds_fence();
}

__device__ __forceinline__ void ln1_router_phase(const Args& a, int l, LAS unsigned char* lds, const int tid, const int rpt) {
    const int lane = tid & 63, wave = __builtin_amdgcn_readfirstlane(tid >> 6);
    unsigned char* ws = a.ws;
    const bf16_t* ypre = (const bf16_t*)(ws + WS_YPRE); bf16_t* x1b = (bf16_t*)(ws + WS_X1B); unsigned char* x1q = ws + WS_X1Q;
    const float* g1 = a.in[8] + l * 1024; const float* b1 = a.in[9] + l * 1024; const float* rw = a.in[10] + (size_t)l * 1024 * 32; const float* rb = a.in[11] + l * 32;
    int* cnt = (int*)(ws + WS_CTL) + l * 32; int* slot_e = (int*)(ws + WS_SLOTE); int* slot_pos = (int*)(ws + WS_SLOTPOS); float* slot_g = (float*)(ws + WS_SLOTG);
    LAS float* X = (LAS float*)lds; LAS float* PART = X + 16 * 1028; LAS float* LG = PART + 8 * 512;
    LAS int* LCNT = (LAS int*)(LG + 512); LAS int* LBASE = LCNT + 32; LAS int* LSLOT = LBASE + 32; constexpr int MAXLOC = 16; LAS float* TV = (LAS float*)(LSLOT + MAXLOC * 64);
    if (tid < 32) LCNT[tid] = 0;
    __syncthreads();
    int iloc = 0;
    f32x4 gv[4], bv[4];
#pragma unroll
    for (int j = 0; j < 4; ++j) { gv[j] = *(const f32x4*)(g1 + 4 * (64 * j + lane)); bv[j] = *(const f32x4*)(b1 + 4 * (64 * j + lane)); }
    const int r16 = lane & 15, kq = lane >> 4, kb = wave * 128;
    float w0[32], w1[32];
#pragma unroll
    for (int ks = 0; ks < 32; ++ks) { const int k = kb + 4 * ks + kq; w0[ks] = rw[k * 32 + r16]; w1[ks] = rw[k * 32 + 16 + r16]; }
    u32x2 pre[2][4];
    { const int t0 = blockIdx.x;
      if (t0 < NTOK / 16) {
#pragma unroll
        for (int rr = 0; rr < 2; ++rr)
#pragma unroll
            for (int j = 0; j < 4; ++j) pre[rr][j] = *(const u32x2*)(ypre + (size_t)(t0 * 16 + 2 * wave + rr) * 1024 + 4 * (64 * j + lane)); } }
    for (int tile = blockIdx.x; tile < NTOK / 16; tile += gridDim.x) {
        const int tok0 = tile * 16;
#pragma unroll
        for (int rr = 0; rr < 2; ++rr) { const int lr = 2 * wave + rr;
            f32x4 v[4]; float s = 0.f;
#pragma unroll
            for (int j = 0; j < 4; ++j) { const u32x2 w = pre[rr][j]; v[j] = (f32x4){bflo(w.x), bfhi(w.x), bflo(w.y), bfhi(w.y)}; s += (v[j][0] + v[j][1]) + (v[j][2] + v[j][3]); }
            const float mean = wave_sum(s, lane) * (1.f / 1024.f); float s2 = 0.f;
#pragma unroll
            for (int j = 0; j < 4; ++j) { v[j] = v[j] - mean; s2 += (v[j][0] * v[j][0] + v[j][1] * v[j][1]) + (v[j][2] * v[j][2] + v[j][3] * v[j][3]); }
            const float rstd = rsqrtf(wave_sum(s2, lane) * (1.f / 1024.f) + LN_EPS);
#pragma unroll
            for (int j = 0; j < 4; ++j) { const f32x4 y = v[j] * rstd * gv[j] + bv[j];
                u32x2 w; w.x = pk2(y[0], y[1]); w.y = pk2(y[2], y[3]); *(u32x2*)(x1b + (size_t)(tok0 + lr) * 1024 + 4 * (64 * j + lane)) = w;
                *(unsigned*)(x1q + (size_t)(tok0 + lr) * 1024 + 4 * (64 * j + lane)) = pk4_fp8(y[0], y[1], y[2], y[3]);
                *(LAS f32x4*)(X + lr * 1028 + 4 * (64 * j + lane)) = y; } }
        __syncthreads();
        { const int nt = tile + gridDim.x;
          if (nt < NTOK / 16) {
#pragma unroll
            for (int rr = 0; rr < 2; ++rr)
#pragma unroll
                for (int j = 0; j < 4; ++j) pre[rr][j] = *(const u32x2*)(ypre + (size_t)(nt * 16 + 2 * wave + rr) * 1024 + 4 * (64 * j + lane)); } }
        { f32x4 acc0 = {0.f, 0.f, 0.f, 0.f}, acc1 = {0.f, 0.f, 0.f, 0.f};
#pragma unroll
          for (int ks = 0; ks < 32; ++ks) { const float av = X[r16 * 1028 + kb + 4 * ks + kq];
              acc0 = __builtin_amdgcn_mfma_f32_16x16x4f32(av, w0[ks], acc0, 0, 0, 0); acc1 = __builtin_amdgcn_mfma_f32_16x16x4f32(av, w1[ks], acc1, 0, 0, 0); }
#pragma unroll
          for (int j = 0; j < 4; ++j) { PART[wave * 512 + (4 * kq + j) * 32 + r16] = acc0[j]; PART[wave * 512 + (4 * kq + j) * 32 + 16 + r16] = acc1[j]; } }
        __syncthreads();
        { float s = rb[tid & 31];
#pragma unroll
          for (int w = 0; w < 8; ++w) s += PART[w * 512 + tid];
          LG[tid] = s; }
        __syncthreads();
        { const int t = tid >> 5, e = tid & 31; const float v = LG[tid]; int rank = 0;
#pragma unroll 8
          for (int j = 0; j < 32; ++j) { const float o = LG[t * 32 + j]; rank += (o > v || (o == v && j < e)) ? 1 : 0; }
          const bool sel = rank < 4;
          if (sel) TV[t * 4 + rank] = v;
          lds_fence();
          if (sel) { const float m = TV[t * 4], den = ((__expf(TV[t * 4] - m) + __expf(TV[t * 4 + 1] - m)) + __expf(TV[t * 4 + 2] - m)) + __expf(TV[t * 4 + 3] - m);
              const float gate = __expf(v - m) * (1.0f / den); const int tok = tok0 + t, k = rank;
              if (rpt == 0) { const int s = tok * 4 + k; slot_e[s] = e; slot_g[s] = gate;
                  if (iloc < MAXLOC) { const int lpos = atomicAdd((int*)&LCNT[e], 1); LSLOT[iloc * 64 + t * 4 + k] = (e << 16) | lpos; }
                  else { const int pos = atomicAdd(cnt + e, 1); slot_pos[s] = pos; } } }
          lds_fence(); }
        ++iloc;
    }
    __syncthreads();
    if (rpt == 0) {
        if (tid < 32) LBASE[tid] = atomicAdd(cnt + tid, LCNT[tid]);
        __syncthreads();
        const int nl = (iloc < MAXLOC ? iloc : MAXLOC) * 64;
        for (int j = tid; j < nl; j += 512) { const int v = LSLOT[j], e = v >> 16, lpos = v & 0xffff, i = j >> 6, t = (j >> 2) & 15, k = j & 3;
            slot_pos[(((int)blockIdx.x + i * (int)gridDim.x) * 16 + t) * 4 + k] = LBASE[e] + lpos; }
    }
}

__device__ __forceinline__ void build_tab(const int* cnt, LAS int* TAB, const int tid) {
    if (tid == 0) { int s = 0; for (int e = 0; e < NEXP; ++e) { TAB[e] = s; s += (cnt[e] + 255) >> 8; } TAB[NEXP] = s; }
    __syncthreads();
}

__device__ __forceinline__ void run_phase(const Args& a, const int ph, LAS unsigned char* lds, const int tid, const int rpt) {
    const int lane = tid & 63, wave = __builtin_amdgcn_readfirstlane(tid >> 6), G = gridDim.x;
    const int gw = blockIdx.x * 8 + wave, NGW = G * 8;
    unsigned char* ws = a.ws;
    bf16_t* hbuf = (bf16_t*)(ws + WS_HBUF); bf16_t* mixed = (bf16_t*)(ws + WS_MIXED); float* kvbuf = (float*)(ws + WS_KV);
    const float* rot = (const float*)(ws + WS_ROT);
    LAS int* TAB = (LAS int*)(lds + TAB_OFF);
    {
        if (ph == 0) { phase_prologue(a, lds, tid); }
        else {
            const int l = (ph - 1) / 10, sp = (ph - 1) % 10;
            int* cnt = (int*)(ws + WS_CTL) + l * 32; float* kmax2 = (float*)(ws + WS_CTL + 1024) + l * 12;
            if (sp == 0) {
                pg8::DenseOrder S; S.init(ws + WS_XB, ws + WS_WIN + (size_t)l * INWP * 1024 * 2, NTOK, INWP, 1024, G, blockIdx.x);
                pg8::EpiBf16Bias E{hbuf, INWP, (const float*)(ws + WS_BPAD) + l * INWP};
                pg8::gemm_phase<false, false>(lds, tid, 1024, S, E);
            } else if (sp == 1) {
                for (int it = gw; it < (NTOK / 16) * 4; it += NGW) pool_item(hbuf, (const bf16_t*)(ws + WS_POOLW) + l * 4 * 4096, a.in[4] + l * 256, mixed, it, lane);
                LAS bf16_t* wl = (LAS bf16_t*)(lds + wave * 18432);
                for (int it = gw; it < 12 * NCHUNK; it += NGW) retkv_item(hbuf, rot, kvbuf, wl, it, lane);
                for (int it = gw; it < 12 * NCHUNK; it += NGW) knorm_item(hbuf, kmax2, it, lane);
            } else if (sp == 2) {
                if (wave < 3) {
                    for (int idx = blockIdx.x * 192 + tid; idx < 12 * 4096; idx += G * 192) { const int bh = idx >> 12, el = idx & 4095, h = bh % 6;
                        const float g64 = exp2f(64.f * log2_gamma(h)); const float* p = kvbuf + (size_t)bh * NCHUNK * 4096 + el; float* pd = (float*)(ws + WS_RPREV) + (size_t)bh * NCHUNK * 4096 + el; float rr = 0.f;
                        for (int n = 0; n < NCHUNK; n += 32) { float t[32];
#pragma unroll
                            for (int i = 0; i < 32; ++i) t[i] = p[(size_t)(n + i) * 4096];
#pragma unroll
                            for (int i = 0; i < 32; ++i) { pd[(size_t)(n + i) * 4096] = rr; rr = g64 * rr + t[i]; } } }
                }
                { unsigned* qctr = (unsigned*)(ws + WS_BAR) + l * 16;
                  LAS bf16_t* vT = (LAS bf16_t*)(lds + wave * 9216);
                  if (rpt == 0) {
                      const int nstat = (4 * NGW <= 12 * 1024) ? 4 * NGW : 0;
                      if (nstat) for (int it = 4 * gw; it < 4 * gw + 4; ++it) sb_item(hbuf, kmax2, mixed, vT, it, lane);
                      for (;;) { int it0 = 0; if (lane == 0) it0 = (int)atomicAdd(qctr, 2u); it0 = nstat + __builtin_amdgcn_readfirstlane(it0); if (it0 >= 12 * 1024) break;
                          for (int it = it0; it < it0 + 2; ++it) sb_item(hbuf, kmax2, mixed, vT, it, lane); } }
                  else { for (int it = gw; it < 12 * 1024; it += NGW) sb_item(hbuf, kmax2, mixed, vT, it, lane); } }
            } else if (sp == 3) {
                LAS bf16_t* vT = (LAS bf16_t*)(lds + wave * 18432);
                for (int it = gw; it < 12 * NCHUNK; it += NGW) retout_item(hbuf, rot, (const float*)(ws + WS_RPREV), a.in[5] + l * 384, mixed, vT, it, lane);
            } else if (sp == 4) {
                pg8::DenseOrder S; S.init(mixed, ws + WS_WOUT + (size_t)l * 1024 * 1024 * 2, NTOK, 1024, 1024, G, blockIdx.x);
                pg8::EpiResBf16 E{(bf16_t*)(ws + WS_YPRE), (const bf16_t*)(ws + WS_XB), a.in[7] + l * 1024};
                pg8::gemm_phase<false, false>(lds, tid, 1024, S, E);
            } else if (sp == 5) {
                ln1_router_phase(a, l, lds, tid, rpt);
            } else if (sp == 6) {
                build_tab(cnt, TAB, tid);
                const int* slot_e = (const int*)(ws + WS_SLOTE); const int* slot_pos = (const int*)(ws + WS_SLOTPOS); int* rowslot = (int*)(ws + WS_ROWSLOT);
                const float* slot_g = (const float*)(ws + WS_SLOTG); float* rowgate = (float*)(ws + WS_ROWGATE);
                for (int s = blockIdx.x * 512 + tid; s < NTOK * 4; s += G * 512) { const int dest = TAB[slot_e[s]] * 256 + slot_pos[s]; rowslot[dest] = s; rowgate[dest] = slot_g[s]; }
                for (int i = blockIdx.x * 512 + tid; i < NEXP * 256; i += G * 512) { const int e = i >> 8, r = cnt[e] + (i & 255); if (r < ((cnt[e] + 255) & ~255)) { rowslot[TAB[e] * 256 + r] = 0; rowgate[TAB[e] * 256 + r] = 0.f; } }
            } else if (sp == 7) {
                build_tab(cnt, TAB, tid);
                pg8::GroupedOrder S; S.init(ws + WS_X1Q, ws + WS_WGU + (size_t)l * 32 * 2048 * 1024, TAB, 2048, 512, G, blockIdx.x);
                { LAS unsigned short* RT = (LAS unsigned short*)(lds + TAB_OFF + 256); const int* rowslot = (const int*)(ws + WS_ROWSLOT);
                  for (int idx = tid; idx < 31 * 256; idx += 512) { pg8::Unit u; if (S.next(idx >> 8, u)) RT[idx] = (unsigned short)(rowslot[u.pm * 256 + (idx & 255)] >> 2); }
                  __syncthreads(); S.rt = RT; }
                pg8::EpiSwiGLU E{ws + WS_ACT, a.in[13] + (size_t)l * 32 * 2048};
                pg8::gemm_phase<true, true>(lds, tid, 512, S, E);
            } else if (sp == 8) {
                build_tab(cnt, TAB, tid);
                pg8::GroupedOrder S; S.init(ws + WS_ACT, ws + WS_WDN + (size_t)l * 32 * 1024 * 1024, TAB, 1024, 512, G, blockIdx.x);
                pg8::EpiDown E{(bf16_t*)(ws + WS_YBUF), a.in[15] + (size_t)l * 32 * 1024, (const int*)(ws + WS_ROWSLOT), (const float*)(ws + WS_ROWGATE), TAB, cnt};
                pg8::gemm_phase<false, true>(lds, tid, 512, S, E);
            } else {
                const bf16_t* x1r = (const bf16_t*)(ws + WS_X1B); const bf16_t* yb = (const bf16_t*)(ws + WS_YBUF); bf16_t* xb = (bf16_t*)(ws + WS_XB);
                const float* g2 = a.in[16] + l * 1024; const float* b2 = a.in[17] + l * 1024;
                f32x4 gv[4], bv[4];
#pragma unroll
                for (int j = 0; j < 4; ++j) { gv[j] = *(const f32x4*)(g2 + 4 * (64 * j + lane)); bv[j] = *(const f32x4*)(b2 + 4 * (64 * j + lane)); }
                for (int tok = gw; tok < NTOK; tok += NGW) { f32x4 v[4]; float s = 0.f;
#pragma unroll
                    for (int j = 0; j < 4; ++j) { const int co = 4 * (64 * j + lane); const u32x2 xr = *(const u32x2*)(x1r + (size_t)tok * 1024 + co); f32x4 x = (f32x4){bflo(xr.x), bfhi(xr.x), bflo(xr.y), bfhi(xr.y)} * DN_ALPHA;
#pragma unroll
                        for (int k = 0; k < 4; ++k) { const u32x2 w = *(const u32x2*)(yb + (size_t)(tok * 4 + k) * 1024 + co); x[0] += bflo(w.x); x[1] += bfhi(w.x); x[2] += bflo(w.y); x[3] += bfhi(w.y); }
                        v[j] = x; s += (x[0] + x[1]) + (x[2] + x[3]); }
                    const float mean = wave_sum(s, lane) * (1.f / 1024.f); float s2 = 0.f;
#pragma unroll
                    for (int j = 0; j < 4; ++j) { v[j] = v[j] - mean; s2 += (v[j][0] * v[j][0] + v[j][1] * v[j][1]) + (v[j][2] * v[j][2] + v[j][3] * v[j][3]); }
                    const float rstd = rsqrtf(wave_sum(s2, lane) * (1.f / 1024.f) + LN_EPS);
#pragma unroll
                    for (int j = 0; j < 4; ++j) { const int co = 4 * (64 * j + lane); const f32x4 y = v[j] * rstd * gv[j] + bv[j];
                        if (l + 1 == DEPTH) *(f32x4*)(a.out + (size_t)tok * 1024 + co) = y;
                        else { u32x2 w; w.x = pk2(y[0], y[1]); w.y = pk2(y[2], y[3]); *(u32x2*)(xb + (size_t)tok * 1024 + co) = w; } } }
            }
        }
    }
}
__global__ void __launch_bounds__(512, 2) mega(Args a) {
    extern __shared__ __attribute__((aligned(16))) unsigned char lds_raw[];
    LAS unsigned char* lds = (LAS unsigned char*)lds_raw;
    volatile LAS unsigned* stw = (volatile LAS unsigned*)(lds + XBST_OFF);
    if (threadIdx.x < 4) stw[threadIdx.x] = 0u;
    const int wave_s = __builtin_amdgcn_readfirstlane((int)(threadIdx.x >> 6));
    __syncthreads();
    XcdBarrier bar; bar.bar = (unsigned*)(a.ws + WS_BAR); bar.x = 0; bar.st = stw;
    if (a.coop) bar = xcd_barrier_post((unsigned*)(a.ws + WS_BAR), stw);
    for (int ph = a.ph_lo; ph < a.ph_hi; ++ph) {
        const int nrep = 1 + ((a.rep >> ph) & 1) * a.nrep;
        for (int rpt = 0; rpt < nrep; ++rpt) {
            unsigned zs = 0u; asm volatile("" : "+s"(zs));
            int tid = wave_s * 64 + (int)__builtin_amdgcn_mbcnt_hi(~0u, __builtin_amdgcn_mbcnt_lo(~0u, zs)); asm volatile("" : "+v"(tid));
            run_phase(a, ph, lds, tid, rpt);
            if (a.coop && (ph + 1 < a.ph_hi || rpt + 1 < nrep)) { if (a.coop == 2) cg::this_grid().sync(); else xcd_barrier(bar, tid); }
            else __syncthreads();
        }
    }
}
#ifdef MK_DIAG
template <int PH> __global__ void __launch_bounds__(512, 2) mega_one(Args a) {
    extern __shared__ __attribute__((aligned(16))) unsigned char lds_raw[];
    run_phase(a, PH, (LAS unsigned char*)lds_raw, threadIdx.x, 0);
}
template __global__ void mega_one<0>(Args); template __global__ void mega_one<1>(Args); template __global__ void mega_one<2>(Args); template __global__ void mega_one<3>(Args);
template __global__ void mega_one<4>(Args); template __global__ void mega_one<5>(Args); template __global__ void mega_one<6>(Args); template __global__ void mega_one<7>(Args);
template __global__ void mega_one<8>(Args); template __global__ void mega_one<9>(Args); template __global__ void mega_one<10>(Args);
#endif

#ifndef MK_REP
#define MK_REP 0
#endif
#ifndef MK_NREP
#define MK_NREP 1
#endif
#ifndef MK_MULTI
#define MK_MULTI 0
#endif
extern "C" void kernel_launch(void* const* d_in, const int* in_sizes, int n_in, void* d_out, int out_size, void* d_ws, size_t ws_size, hipStream_t stream) {
    static int grid = 0;
    if (grid == 0) {
        if (n_in != 18 || ws_size < WS_END) { fprintf(stderr, "kernel_launch: unexpected n_in %d or ws_size %zu (< %zu)\n", n_in, ws_size, (size_t)WS_END); grid = -1; return; }
        int dev = 0, cus = 0, per_cu = 0;
        hipGetDevice(&dev); hipDeviceGetAttribute(&cus, hipDeviceAttributeMultiprocessorCount, dev);
        if (hipFuncSetAttribute((const void*)mega, hipFuncAttributeMaxDynamicSharedMemorySize, LDS_BYTES) != hipSuccess) { fprintf(stderr, "kernel_launch: hipFuncSetAttribute failed\n"); grid = -1; return; }
        if (hipOccupancyMaxActiveBlocksPerMultiprocessor(&per_cu, (const void*)mega, 512, LDS_BYTES) != hipSuccess || per_cu < 1) { fprintf(stderr, "kernel_launch: occupancy query says %d\n", per_cu); per_cu = 1; }
        (void)hipGetLastError();
        grid = cus * 1;
    }
    if (grid < 0) return;
    Args a{};
    for (int i = 0; i < 18; ++i) a.in[i] = (const float*)d_in[i];
    a.out = (float*)d_out; a.ws = (unsigned char*)d_ws; a.rep = MK_REP; a.nrep = MK_NREP;
#if MK_MULTI
    for (int ph = 0; ph < 21; ++ph) { a.ph_lo = ph; a.ph_hi = ph + 1; a.coop = 0; hipLaunchKernelGGL(mega, dim3(grid), dim3(512), LDS_BYTES, stream, a); }
#else
    a.ph_lo = 0; a.ph_hi = 21; a.coop = 1;
    if (hipMemsetAsync((char*)d_ws + WS_BAR, 0, 16384, stream) != hipSuccess) { fprintf(stderr, "kernel_launch: memset of barrier words failed\n"); return; }
    void* args[] = {&a};
    hipError_t e = hipLaunchCooperativeKernel((const void*)mega, dim3(grid), dim3(512), args, LDS_BYTES, stream);
    if (e != hipSuccess) fprintf(stderr, "cooperative launch failed: %s (grid %d)\n", hipGetErrorString(e), grid);
#endif
}
```

```cpp
#include <hip/hip_runtime.h>
#include <hip/hip_cooperative_groups.h>
#include <cstdio>
#include <cstdint>
namespace cg = cooperative_groups;

#define LAS __attribute__((address_space(3)))
typedef unsigned short bf16_t;
typedef short bf16x8 __attribute__((ext_vector_type(8)));
typedef float f32x4 __attribute__((ext_vector_type(4)));
typedef unsigned u32x4 __attribute__((ext_vector_type(4)));
typedef unsigned u32x2 __attribute__((ext_vector_type(2)));
typedef int i32x8 __attribute__((ext_vector_type(8)));
typedef int i32x4 __attribute__((ext_vector_type(4)));

constexpr int NTOK = 32768, SEQ = 16384, DM = 1024, INW = 2944, INWP = 3072, NEXP = 32, DEPTH = 2;
constexpr int NCHUNK = 256;
constexpr int C_SBQ = 256, C_SBK = 640, C_SBV = 1024, C_RQ = 1408, C_RK = 1792, C_RV = 2176, C_RG = 2560;
constexpr int M_SB = 256, M_RET = 640;
constexpr float DN_ALPHA = 1.41421356237f, LN_EPS = 1e-5f;
constexpr int PROWS = 131072 + NEXP * 256;
constexpr float W8_SCALE = 64.0f, ACT8_SCALE = 8.0f;
constexpr int LDS_BYTES = 147456 + 64, TAB_OFF = 131072, XBST_OFF = 147456;

constexpr size_t WS_CTL = 0;
constexpr size_t WS_BPAD = 4096;
constexpr size_t WS_ROT = 32768;
constexpr size_t WS_WIN = WS_ROT + 2ull * 16384 * 32 * 4;
constexpr size_t WS_WOUT = WS_WIN + 2ull * INWP * 1024 * 2;
constexpr size_t WS_WGU = WS_WOUT + 2ull * 1024 * 1024 * 2;
constexpr size_t WS_WDN = WS_WGU + 2ull * 32 * 2048 * 1024 * 2;
constexpr size_t WS_XB = WS_WDN + 2ull * 32 * 1024 * 1024 * 2;
constexpr size_t WS_HBUF = WS_XB + (size_t)NTOK * 1024 * 2;
constexpr size_t WS_MIXED = WS_HBUF + (size_t)NTOK * INWP * 2;
constexpr size_t WS_KV = WS_MIXED + (size_t)NTOK * 1024 * 2;
constexpr size_t WS_YPRE = WS_KV + 12ull * 256 * 4096 * 4;
constexpr size_t WS_X1B = WS_YPRE + (size_t)NTOK * 1024 * 4;
constexpr size_t WS_XS = WS_X1B + (size_t)NTOK * 1024 * 2;
constexpr size_t WS_ACT = WS_XS + (size_t)PROWS * 1024 * 2;
constexpr size_t WS_YBUF = WS_ACT + (size_t)PROWS * 1024 * 2;
constexpr size_t WS_SLOTE = WS_YBUF + 131072ull * 1024 * 2;
constexpr size_t WS_SLOTPOS = WS_SLOTE + 131072ull * 4;
constexpr size_t WS_SLOTG = WS_SLOTPOS + 131072ull * 4;
constexpr size_t WS_ROWSLOT = WS_SLOTG + 131072ull * 4;
constexpr size_t WS_POOLW = WS_ROWSLOT + (size_t)PROWS * 4;
constexpr size_t WS_ROWGATE = WS_POOLW + 2ull * 4 * 4096 * 2;
constexpr size_t WS_BAR = WS_ROWGATE + (size_t)PROWS * 4;
constexpr size_t WS_X1Q = WS_XS;
constexpr size_t WS_RPREV = WS_XS + (128ull << 20);
constexpr size_t WS_END = WS_BAR + 16384;

__device__ __forceinline__ unsigned pk2(float lo, float hi) { unsigned r; asm("v_cvt_pk_bf16_f32 %0, %1, %2" : "=v"(r) : "v"(lo), "v"(hi)); return r; }
__device__ __forceinline__ unsigned pk4_fp8(float a, float b, float c, float d) { int w = 0; w = __builtin_amdgcn_cvt_pk_fp8_f32(a, b, w, false); w = __builtin_amdgcn_cvt_pk_fp8_f32(c, d, w, true); return (unsigned)w; }
__device__ __forceinline__ float bflo(unsigned u) { return __uint_as_float(u << 16); }
__device__ __forceinline__ float bfhi(unsigned u) { return __uint_as_float(u & 0xffff0000u); }
__device__ __forceinline__ float bf1(bf16_t b) { return __uint_as_float((unsigned)b << 16); }
__device__ __forceinline__ float sx(float v, int m, int lane) { return __builtin_bit_cast(float, __builtin_amdgcn_ds_bpermute((lane ^ m) << 2, __builtin_bit_cast(int, v))); }
__device__ __forceinline__ float sl(float v, int src) { return __builtin_bit_cast(float, __builtin_amdgcn_ds_bpermute(src << 2, __builtin_bit_cast(int, v))); }
__device__ __forceinline__ float wave_sum(float v, int) {
#define WS_DPP(ctrl, rmask) v += __builtin_bit_cast(float, __builtin_amdgcn_update_dpp(0, __builtin_bit_cast(int, v), ctrl, rmask, 0xF, false))
    WS_DPP(0xB1, 0xF);
    WS_DPP(0x4E, 0xF);
    WS_DPP(0x141, 0xF);
    WS_DPP(0x140, 0xF);
    WS_DPP(0x142, 0xA);
    WS_DPP(0x143, 0xC);
#undef WS_DPP
    return __builtin_bit_cast(float, __builtin_amdgcn_readlane(__builtin_bit_cast(int, v), 63));
}
__device__ __forceinline__ void lds_fence() { asm volatile("s_waitcnt lgkmcnt(0)" ::: "memory"); }
__device__ __forceinline__ bf16x8 as_bf16x8(u32x4 v) { return __builtin_bit_cast(bf16x8, v); }

namespace pg8 {
constexpr int BM = 256, BK = 64, HALF = 128, HTB = HALF * BK * 2, STAGE_BYTES = 8 * HTB, NXCD = 8, WGM = 8;
__device__ __forceinline__ int lds_byte(int r, int c) { const int st = (r >> 4) * 2 + (c >> 5), rr = r & 15, cc = c & 31, ob = rr * 64 + cc * 2; return st * 1024 + (ob ^ (((ob >> 9) & 1) << 5)); }
__device__ __forceinline__ void stage_rc(int b, int& R, int& C) { const int st = b / 1024, sb = b % 1024, swz = sb ^ (((sb >> 9) & 1) << 5); R = (st >> 1) * 16 + swz / 64; C = (st & 1) * 32 + (swz % 64) / 2; }
__device__ __forceinline__ int perm32(int rho) { const int n = rho >> 4, i = rho & 15; return 8 * (i >> 2) + 4 * n + (i & 3); }

struct Unit { int pm, pn, e; };

struct DenseOrder {
    static constexpr LAS const unsigned short* rt = nullptr;
    const char* A; const char* Bt; int nM, nN, nwg, G, c; size_t tstep;
    __device__ void init(const void* A_, const void* Bt_, int M, int N, int K, int G_, int c_) { A = (const char*)A_; Bt = (const char*)Bt_; nM = M / BM; nN = N / BM; nwg = nM * nN; G = G_; c = c_; tstep = (size_t)BM * K * 2; }
    __device__ bool next(int i, Unit& u) const {
        const long L = (long)i * G + c; if (L >= nwg) return false;
        int wgid = (int)L; { const int q = nwg / NXCD, r = nwg % NXCD, xcd = wgid % NXCD, off = wgid / NXCD; wgid = (xcd < r ? xcd * (q + 1) : r * (q + 1) + (xcd - r) * q) + off; }
        const int nig = WGM * nN, gid = wgid / nig, fm = gid * WGM, gsz = (nM - fm) < WGM ? (nM - fm) : WGM;
        u.pm = fm + ((wgid % nig) % gsz); u.pn = (wgid % nig) / gsz; u.e = 0; return true;
    }
    __device__ __forceinline__ const char* aptr(const Unit& u) const { return A + (size_t)u.pm * tstep; }
    __device__ __forceinline__ const char* bptr(const Unit& u) const { return Bt + (size_t)u.pn * tstep; }
};
struct GroupedOrder {
    const char* A; const char* Bt; LAS const int* mpre; LAS const unsigned short* rt; int nN, G, c, MT; size_t tstep, estep;
    __device__ void init(const void* A_, const void* Bt_, LAS const int* mpre_, int N, int K, int G_, int c_) { rt = nullptr; A = (const char*)A_; Bt = (const char*)Bt_; mpre = mpre_; nN = N / BM; G = G_; c = c_; MT = __builtin_amdgcn_readfirstlane(mpre_[NEXP]); tstep = (size_t)BM * K * 2; estep = (size_t)N * K * 2; }
    __device__ bool next(int i, Unit& u) const {
        int mt, pn;
        if ((G & 7) == 0 && (G >> 3) % nN == 0) { const int xcd = c & 7, j = c >> 3, per = (G >> 3) / nN; pn = j % nN; mt = (i * per + j / nN) * 8 + xcd; }
        else { const int L = i * G + c; mt = L / nN; pn = L % nN; }
        if (mt >= MT) return false;
        u.pm = mt; u.pn = pn; int e = 0;
        for (int j = 1; j < NEXP; ++j) e += (mpre[j] <= mt) ? 1 : 0;
        u.e = __builtin_amdgcn_readfirstlane(e); return true;
    }
    __device__ __forceinline__ const char* aptr(const Unit& u) const { return rt ? A : A + (size_t)u.pm * tstep; }
    __device__ __forceinline__ const char* bptr(const Unit& u) const { return Bt + (size_t)u.e * estep + (size_t)u.pn * tstep; }
};

template <bool GATHER, bool FP8, class Epi, class Sched>
__device__ __forceinline__ void gemm_phase(LAS unsigned char* lds, const int tid, const int K, const Sched& S, const Epi& E) {
    const int wid = __builtin_amdgcn_readfirstlane(tid >> 6), lane = tid & 63, wr = wid >> 2, wc = wid & 3, fr = lane & 15, fq = lane >> 4;
    const int nt = K / BK;
    int R0, C0; stage_rc(tid * 16, R0, C0); const int Rb0 = Epi::PERM ? ((R0 & ~31) + perm32(R0 & 31)) : R0;
    unsigned voffA[2], voffB[2];
    voffA[0] = (unsigned)(R0 * K + C0) * 2u; voffA[1] = voffA[0] + (unsigned)(64 * K * 2);
    voffB[0] = (unsigned)(Rb0 * 128 + C0 * 2); voffB[1] = voffB[0] + 64u * 128u;
    const size_t kstepB = 32768, hstepB = 16384;
    const size_t kstep = (size_t)(BK * 2);
    const size_t hstep = (size_t)HALF * K * 2;
    const size_t hsA = GATHER ? (size_t)0 : hstep;
    unsigned oC[2][2], o2[2][2];
#define PG8_LOADOFF(dst, round) do { _Pragma("unroll") for (int _i = 0; _i < 2; ++_i) \
        _Pragma("unroll") for (int _h = 0; _h < 2; ++_h) dst[_h][_i] = GATHER ? ((unsigned)S.rt[(round) * 256 + _h * 128 + _i * 64 + R0] * (unsigned)(K * 2) + (unsigned)(C0 * 2)) : voffA[_i]; } while (0)
    const unsigned ldsw = (unsigned)wid * 1024u;
    const int aoff = lds_byte(wr * 64 + fr, fq * 8), boff = lds_byte(wc * 32 + fr, fq * 8);
#define PG8_SA(b, h) (((b) * 2 + (h)) * HTB)
#define PG8_SB(b, h) ((4 + (b) * 2 + (h)) * HTB)
#define PG8_STAGE(bufoff, gbase, voff) do { _Pragma("unroll") for (int _i = 0; _i < 2; ++_i) \
        __builtin_amdgcn_global_load_lds((const unsigned*)((const char*)(gbase) + (voff)[_i]), (LAS unsigned*)(lds + (bufoff) + ldsw + _i * 8192), 16, 0, 0); } while (0)
#define PG8_LD16(off) (*(const LAS i32x4*)(lds + (off)))
#define PG8_LDA(dst, b, h) do { if constexpr (FP8) { _Pragma("unroll") for (int m = 0; m < 4; ++m) dst##8[m] = __builtin_shufflevector(PG8_LD16(PG8_SA(b, h) + aoff + m * 2048), PG8_LD16(PG8_SA(b, h) + aoff + m * 2048 + 1024), 0, 1, 2, 3, 4, 5, 6, 7); } \
        else { _Pragma("unroll") for (int m = 0; m < 4; ++m) _Pragma("unroll") for (int k = 0; k < 2; ++k) dst[m][k] = *(const LAS bf16x8*)(lds + PG8_SA(b, h) + aoff + m * 2048 + k * 1024); } } while (0)
#define PG8_LDB(dst, b, h) do { if constexpr (FP8) { _Pragma("unroll") for (int n = 0; n < 2; ++n) dst##8[n] = __builtin_shufflevector(PG8_LD16(PG8_SB(b, h) + boff + n * 2048), PG8_LD16(PG8_SB(b, h) + boff + n * 2048 + 1024), 0, 1, 2, 3, 4, 5, 6, 7); } \
        else { _Pragma("unroll") for (int n = 0; n < 2; ++n) _Pragma("unroll") for (int k = 0; k < 2; ++k) dst[n][k] = *(const LAS bf16x8*)(lds + PG8_SB(b, h) + boff + n * 2048 + k * 1024); } } while (0)
#define PG8_MMA(ai, bj, At, Bt) do { __builtin_amdgcn_s_setprio(1); \
        if constexpr (FP8) { _Pragma("unroll") for (int m = 0; m < 4; ++m) _Pragma("unroll") for (int n = 0; n < 2; ++n) \
            asm volatile("v_mfma_scale_f32_16x16x128_f8f6f4 %0, %1, %2, %0, %3, %3 op_sel_hi:[0,0,0]" : "+v"(acc[ai][bj][m][n]) : "v"(Bt##8[n]), "v"(At##8[m]), "v"(sc8)); } \
        else { _Pragma("unroll") for (int m = 0; m < 4; ++m) _Pragma("unroll") for (int n = 0; n < 2; ++n) _Pragma("unroll") for (int k = 0; k < 2; ++k) \
            acc[ai][bj][m][n] = __builtin_amdgcn_mfma_f32_16x16x32_bf16(Bt[n][k], At[m][k], acc[ai][bj][m][n], 0, 0, 0); } \
        __builtin_amdgcn_s_setprio(0); } while (0)
#define PG8_WAIT_V(n) asm volatile("s_waitcnt vmcnt(" #n ")" ::: "memory")
#define PG8_WAIT_L(n) asm volatile("s_waitcnt lgkmcnt(" #n ")" ::: "memory")
#define PG8_BAR __builtin_amdgcn_s_barrier()
#define PG8_SCHED __builtin_amdgcn_sched_barrier(0)
    Unit cur, nxt; int ui = 0;
    if (!S.next(0, cur)) return;
    int sc8 = 0x7f; asm volatile("" : "+v"(sc8));
    float zf = 0.f; asm volatile("" : "+v"(zf));
    f32x4 acc[2][2][4][2];
#pragma unroll
    for (int a = 0; a < 2; ++a)
#pragma unroll
        for (int b = 0; b < 2; ++b)
#pragma unroll
            for (int m = 0; m < 4; ++m)
#pragma unroll
                for (int n = 0; n < 2; ++n) acc[a][b][m][n] = (f32x4){zf, zf, zf, zf};
    bf16x8 At[4][2], B0[2][2], B1[2][2];
    i32x8 At8[4], B08[2], B18[2];
    const char* cA = S.aptr(cur); const char* cB = S.bptr(cur);
    PG8_LOADOFF(oC, 0);
#pragma unroll
    for (int _h = 0; _h < 2; ++_h)
#pragma unroll
        for (int _i = 0; _i < 2; ++_i) o2[_h][_i] = oC[_h][_i];
    PG8_STAGE(PG8_SB(0, 0), cB, voffB); PG8_STAGE(PG8_SB(0, 1), cB + hstepB, voffB); PG8_STAGE(PG8_SA(0, 0), cA, oC[0]); PG8_STAGE(PG8_SA(0, 1), cA + hsA, oC[1]);
    if (wr == 1) PG8_BAR;
    PG8_WAIT_V(2); PG8_BAR;
    PG8_STAGE(PG8_SB(1, 0), cB + kstepB, voffB); PG8_STAGE(PG8_SA(1, 0), cA + kstep, oC[0]); PG8_STAGE(PG8_SB(1, 1), cB + hstepB + kstepB, voffB);
    PG8_WAIT_V(6); PG8_BAR;
    for (;;) {
        const bool has_next = S.next(ui + 1, nxt);
        const char* nA = has_next ? S.aptr(nxt) : cA; const char* nB = has_next ? S.bptr(nxt) : cB;
#pragma unroll 1
        for (int t = 0; t < nt; t += 2) {
            const bool last = (t == nt - 2);
            if (GATHER && last && has_next) { PG8_LOADOFF(o2, ui + 1); }
            const char* a1 = cA + (size_t)(t + 1) * kstep;
            const char* a2 = last ? nA : cA + (size_t)(t + 2) * kstep; const char* b2 = last ? nB : cB + (size_t)(t + 2) * kstepB;
            const char* a3 = a2 + kstep; const char* b3 = b2 + kstepB;
            PG8_LDB(B0, 0, 0); PG8_LDB(B1, 0, 1); PG8_SCHED; PG8_LDA(At, 0, 0); PG8_STAGE(PG8_SA(1, 1), a1 + hsA, oC[1]);
            PG8_WAIT_V(8); PG8_WAIT_L(0); PG8_BAR; PG8_MMA(0, 0, At, B0); PG8_MMA(0, 1, At, B1); PG8_BAR; PG8_SCHED;
            PG8_LDA(At, 0, 1); PG8_STAGE(PG8_SB(0, 0), b2, voffB); PG8_STAGE(PG8_SB(0, 1), b2 + hstepB, voffB); PG8_STAGE(PG8_SA(0, 0), a2, o2[0]);
            PG8_WAIT_V(8); PG8_WAIT_L(0); PG8_BAR; PG8_MMA(1, 0, At, B0); PG8_MMA(1, 1, At, B1); PG8_BAR; PG8_SCHED;
            PG8_LDB(B0, 1, 0); PG8_LDB(B1, 1, 1); PG8_SCHED; PG8_LDA(At, 1, 0); PG8_STAGE(PG8_SA(0, 1), a2 + hsA, o2[1]);
            PG8_WAIT_V(8); PG8_WAIT_L(0); PG8_BAR; PG8_MMA(0, 0, At, B0); PG8_MMA(0, 1, At, B1); PG8_BAR; PG8_SCHED;
            PG8_LDA(At, 1, 1); PG8_STAGE(PG8_SB(1, 0), b3, voffB); PG8_STAGE(PG8_SB(1, 1), b3 + hstepB, voffB); PG8_STAGE(PG8_SA(1, 0), a3, o2[0]);
            PG8_WAIT_V(8); PG8_WAIT_L(0); PG8_BAR; PG8_MMA(1, 0, At, B0); PG8_MMA(1, 1, At, B1); PG8_BAR; PG8_SCHED;
        }
        if (wr == 0) PG8_BAR;
        { int t2 = tid; asm volatile("" : "+v"(t2)); const int l2 = t2 & 63; E(acc, cur, wr, wc, l2 & 15, l2 >> 4); }
        if (!has_next) break;
#pragma unroll
        for (int a = 0; a < 2; ++a)
#pragma unroll
            for (int b = 0; b < 2; ++b)
#pragma unroll
                for (int m = 0; m < 4; ++m)
#pragma unroll
                    for (int n = 0; n < 2; ++n) acc[a][b][m][n] = (f32x4){zf, zf, zf, zf};
        cur = nxt; cA = nA; cB = nB; ++ui;
#pragma unroll
        for (int _h = 0; _h < 2; ++_h)
#pragma unroll
            for (int _i = 0; _i < 2; ++_i) oC[_h][_i] = o2[_h][_i];
        if (wr == 1) PG8_BAR;
    }
    PG8_WAIT_V(0);
    PG8_BAR;
#undef PG8_LOADOFF
#undef PG8_LD16
#undef PG8_SA
#undef PG8_SB
#undef PG8_STAGE
#undef PG8_LDA
#undef PG8_LDB
#undef PG8_MMA
#undef PG8_WAIT_V
#undef PG8_WAIT_L
#undef PG8_BAR
#undef PG8_SCHED
}

struct EpiBf16Bias {
    static constexpr bool PERM = true;
    bf16_t* O; int ldc; const float* bias;
    __device__ __forceinline__ void operator()(const f32x4 (&acc)[2][2][4][2], const Unit& u, int wr, int wc, int fr, int fq) const {
        const int row0 = u.pm * BM + wr * 64 + fr, col0 = u.pn * BM + wc * 32 + 8 * fq;
        f32x4 bv[2][2];
#pragma unroll
        for (int bj = 0; bj < 2; ++bj)
#pragma unroll
            for (int n = 0; n < 2; ++n) bv[bj][n] = *(const f32x4*)(bias + col0 + bj * HALF + 4 * n);
#pragma unroll
        for (int ai = 0; ai < 2; ++ai)
#pragma unroll
            for (int m = 0; m < 4; ++m) { bf16_t* rowp = O + (size_t)(row0 + ai * HALF + m * 16) * ldc + col0;
#pragma unroll
                for (int bj = 0; bj < 2; ++bj) { const f32x4 v0 = acc[ai][bj][m][0] + bv[bj][0], v1 = acc[ai][bj][m][1] + bv[bj][1];
                    u32x4 w; w.x = pk2(v0[0], v0[1]); w.y = pk2(v0[2], v0[3]); w.z = pk2(v1[0], v1[1]); w.w = pk2(v1[2], v1[3]);
                    *(u32x4*)(rowp + bj * HALF) = w; } }
    }
};
struct EpiResBf16 {
    static constexpr bool PERM = true;
    bf16_t* O; const bf16_t* res; const float* bias;
    __device__ __forceinline__ void operator()(const f32x4 (&acc)[2][2][4][2], const Unit& u, int wr, int wc, int fr, int fq) const {
        const int row0 = u.pm * BM + wr * 64 + fr, col0 = u.pn * BM + wc * 32 + 8 * fq;
        f32x4 bv[2][2];
#pragma unroll
        for (int bj = 0; bj < 2; ++bj)
#pragma unroll
            for (int n = 0; n < 2; ++n) bv[bj][n] = *(const f32x4*)(bias + col0 + bj * HALF + 4 * n);
#pragma unroll
        for (int am = 0; am < 4; ++am) { const int ai = am >> 1;
            u32x4 rv[2][2];
#pragma unroll
            for (int mm = 0; mm < 2; ++mm)
#pragma unroll
                for (int bj = 0; bj < 2; ++bj) rv[mm][bj] = *(const u32x4*)(res + (size_t)(row0 + ai * HALF + ((am & 1) * 2 + mm) * 16) * DM + col0 + bj * HALF);
#pragma unroll
            for (int mm = 0; mm < 2; ++mm) { const int m = (am & 1) * 2 + mm; bf16_t* rowp = O + (size_t)(row0 + ai * HALF + m * 16) * DM + col0;
#pragma unroll
                for (int bj = 0; bj < 2; ++bj) { const u32x4 r = rv[mm][bj]; f32x4 v0 = acc[ai][bj][m][0] + bv[bj][0], v1 = acc[ai][bj][m][1] + bv[bj][1];
                    v0[0] += DN_ALPHA * bflo(r.x); v0[1] += DN_ALPHA * bfhi(r.x); v0[2] += DN_ALPHA * bflo(r.y); v0[3] += DN_ALPHA * bfhi(r.y);
                    v1[0] += DN_ALPHA * bflo(r.z); v1[1] += DN_ALPHA * bfhi(r.z); v1[2] += DN_ALPHA * bflo(r.w); v1[3] += DN_ALPHA * bfhi(r.w);
                    u32x4 w; w.x = pk2(v0[0], v0[1]); w.y = pk2(v0[2], v0[3]); w.z = pk2(v1[0], v1[1]); w.w = pk2(v1[2], v1[3]);
                    *(u32x4*)(rowp + bj * HALF) = w; } } }
    }
};
struct EpiSwiGLU {
    static constexpr bool PERM = false;
    unsigned char* ACT; const float* bgu;
    __device__ __forceinline__ void operator()(const f32x4 (&acc)[2][2][4][2], const Unit& u, int wr, int wc, int fr, int fq) const {
        const int row0 = u.pm * BM + wr * 64 + fr, j0 = u.pn * 128 + wc * 16 + 4 * fq;
        const float* be = bgu + (size_t)u.e * 2048;
        f32x4 bg[2], bu[2];
#pragma unroll
        for (int bj = 0; bj < 2; ++bj) { bg[bj] = *(const f32x4*)(be + j0 + bj * 64); bu[bj] = *(const f32x4*)(be + 1024 + j0 + bj * 64); }
#pragma unroll
        for (int ai = 0; ai < 2; ++ai)
#pragma unroll
            for (int m = 0; m < 4; ++m) { unsigned char* rowp = ACT + (size_t)(row0 + ai * HALF + m * 16) * 1024 + j0;
#pragma unroll
                for (int bj = 0; bj < 2; ++bj) { const f32x4 g4 = acc[ai][bj][m][0] * (1.0f / W8_SCALE) + bg[bj], u4 = acc[ai][bj][m][1] * (1.0f / W8_SCALE) + bu[bj]; float o[4];
#pragma unroll
                    for (int i = 0; i < 4; ++i) { const float g = fminf(g4[i], 7.0f), up = __builtin_amdgcn_fmed3f(u4[i], -7.0f, 7.0f);
                        const float rs = __builtin_amdgcn_rcpf(1.0f + __builtin_amdgcn_exp2f(g * -2.45546696f)); o[i] = __builtin_fmaf(up, ACT8_SCALE, ACT8_SCALE) * (g * rs); }
                    *(unsigned*)(rowp + bj * 64) = pk4_fp8(o[0], o[1], o[2], o[3]); } }
    }
};
struct EpiDown {
    static constexpr bool PERM = true;
    bf16_t* Y; const float* bdn; const int* rowslot; const float* slotg; LAS const int* mpre; const int* cnt;
    __device__ __forceinline__ void operator()(const f32x4 (&acc)[2][2][4][2], const Unit& u, int wr, int wc, int fr, int fq) const {
        const int rl0 = wr * 64 + fr, col0 = u.pn * BM + wc * 32 + 8 * fq;
        const int nvalid = cnt[u.e] - (u.pm - mpre[u.e]) * BM;
        const float* be = bdn + (size_t)u.e * 1024;
        f32x4 bv[2][2];
#pragma unroll
        for (int bj = 0; bj < 2; ++bj)
#pragma unroll
            for (int n = 0; n < 2; ++n) bv[bj][n] = *(const f32x4*)(be + col0 + bj * HALF + 4 * n);
        int slots[2][4]; float gts[2][4];
#pragma unroll
        for (int ai = 0; ai < 2; ++ai)
#pragma unroll
            for (int m = 0; m < 4; ++m) { slots[ai][m] = rowslot[u.pm * BM + rl0 + ai * HALF + m * 16]; gts[ai][m] = slotg[u.pm * BM + rl0 + ai * HALF + m * 16]; }
#pragma unroll
        for (int ai = 0; ai < 2; ++ai)
#pragma unroll
            for (int m = 0; m < 4; ++m) { const int rl = rl0 + ai * HALF + m * 16;
                if (rl < nvalid) { const int slot = slots[ai][m]; const float g = gts[ai][m]; bf16_t* rowp = Y + (size_t)slot * 1024 + col0;
#pragma unroll
                    for (int bj = 0; bj < 2; ++bj) { const f32x4 v0 = (acc[ai][bj][m][0] * (1.0f / (W8_SCALE * ACT8_SCALE)) + bv[bj][0]) * g, v1 = (acc[ai][bj][m][1] * (1.0f / (W8_SCALE * ACT8_SCALE)) + bv[bj][1]) * g;
                        u32x4 w; w.x = pk2(v0[0], v0[1]); w.y = pk2(v0[2], v0[3]); w.z = pk2(v1[0], v1[1]); w.w = pk2(v1[2], v1[3]);
                        *(u32x4*)(rowp + bj * HALF) = w; } } }
    }
};
}

#define XB_TMO      128
#define XB_XCNT(j)  (256  + 64 * (j))
#define XB_XSUB(j)  (1280 + 64 * (j))
#define XB_XGEN(j)  (2304 + 64 * (j))
#define XB_TOP      3328
#define XB_TOPGEN   3392
#define XCD_BAR_WORDS 3456
#define XB_SPIN_CAP (1u << 18)
__device__ __forceinline__ unsigned xb_ld(unsigned* p)              { return __hip_atomic_load(p, __ATOMIC_RELAXED, __HIP_MEMORY_SCOPE_AGENT); }
__device__ __forceinline__ unsigned xb_add(unsigned* p, unsigned v) { return __hip_atomic_fetch_add(p, v, __ATOMIC_RELAXED, __HIP_MEMORY_SCOPE_AGENT); }
__device__ __forceinline__ unsigned xb_xcc_id() { return (unsigned)__builtin_amdgcn_s_getreg((3 << 11) | 20) & 0xFu; }
#define XB_SPIN(cond, bar) do { unsigned _sp = 0; while (cond) { __builtin_amdgcn_s_sleep(1); \
    if ((++_sp & 255u) == 0u) { if (xb_ld(&(bar)[XB_TMO])) break; if (_sp > XB_SPIN_CAP) { atomicAdd(&(bar)[XB_TMO], 1u); break; } } } } while (0)
struct XcdBarrier { unsigned* bar; unsigned x; volatile LAS unsigned* st; };
__device__ __forceinline__ XcdBarrier xcd_barrier_post(unsigned* bar, volatile LAS unsigned* st) {
    XcdBarrier b; b.bar = bar; b.x = xb_xcc_id(); b.st = st;
    if (threadIdx.x == 0) (void)xb_add(&bar[XB_XCNT(b.x)], 1u);
    return b;
}
__device__ __forceinline__ void xcd_barrier_complete(unsigned* bar, unsigned x, unsigned& nloc, unsigned& nx) {
    const unsigned G = gridDim.x * gridDim.y * gridDim.z;
    unsigned sum, cnt, mine, sp = 0u;
    for (;;) {
        sum = 0u; cnt = 0u; mine = 0u;
#pragma unroll
        for (unsigned j = 0; j < 16; ++j) { const unsigned c = xb_ld(&bar[XB_XCNT(j)]); sum += c; cnt += (c > 0u) ? 1u : 0u; mine = (j == x) ? c : mine; }
        if (sum == G) break;
        __builtin_amdgcn_s_sleep(1);
        if ((++sp & 255u) == 0u) { if (xb_ld(&bar[XB_TMO])) break; if (sp > XB_SPIN_CAP) { atomicAdd(&bar[XB_TMO], 1u); break; } }
    }
    nloc = mine > 0u ? mine : 1u; nx = cnt > 0u ? cnt : 1u;
}
__device__ __forceinline__ void xcd_barrier(const XcdBarrier& b, const int tid0) {
    asm volatile("s_waitcnt vmcnt(0)" ::: "memory");
    __syncthreads();
    if (tid0 == 0) {
        unsigned* bar = b.bar;
        __builtin_amdgcn_s_waitcnt(0);
        unsigned nloc = b.st[0], nx = b.st[1];
        if (nloc == 0u) { xcd_barrier_complete(bar, b.x, nloc, nx); b.st[0] = nloc; b.st[1] = nx; }
        const unsigned old = xb_add(&bar[XB_XSUB(b.x)], 1u);
        const unsigned gen = old / nloc;
        if (old + 1u == (gen + 1u) * nloc) {
            __builtin_amdgcn_fence(__ATOMIC_RELEASE, "agent");
            asm volatile("s_waitcnt vmcnt(0)" ::: "memory");
            const unsigned og = xb_add(&bar[XB_TOP], 1u);
            const unsigned tg = og / nx;
            if (og + 1u == (tg + 1u) * nx) xb_add(&bar[XB_TOPGEN], 1u);
            else XB_SPIN(xb_ld(&bar[XB_TOPGEN]) == tg, bar);
            __builtin_amdgcn_fence(__ATOMIC_ACQUIRE, "agent");
            xb_add(&bar[XB_XGEN(b.x)], 1u);
            asm volatile("s_waitcnt vmcnt(0)" ::: "memory");
        } else {
            XB_SPIN(xb_ld(&bar[XB_XGEN(b.x)]) == gen, bar);
            __builtin_amdgcn_fence(__ATOMIC_ACQUIRE, "agent");
            asm volatile("s_waitcnt vmcnt(0)" ::: "memory");
        }
    }
    __syncthreads();
}

struct Args { const float* in[18]; float* out; unsigned char* ws; int ph_lo, ph_hi, coop, rep, nrep, pad; };

struct P0Item { const float* W; bf16_t* WT; int N, mode, k0, n0; };
__device__ __forceinline__ P0Item p0_decode(const Args& a, int it) {
    constexpr int IN_IT = 16 * 46, OUT_IT = 256, GU_IT = 512, DN_IT = 256, LAYER_IT = IN_IT + OUT_IT + 32 * GU_IT + 32 * DN_IT;
    unsigned char* ws = a.ws; P0Item p; p.mode = 0;
    const int l = it / LAYER_IT; int r = it % LAYER_IT;
    if (r < IN_IT) { p.W = a.in[1] + (size_t)l * 1024 * INW; p.N = INW; p.WT = (bf16_t*)(ws + WS_WIN) + (size_t)l * INWP * 1024; }
    else if ((r -= IN_IT) < OUT_IT) { p.W = a.in[6] + (size_t)l * 1024 * 1024; p.N = 1024; p.WT = (bf16_t*)(ws + WS_WOUT) + (size_t)l * 1024 * 1024; }
    else if ((r -= OUT_IT) < 32 * GU_IT) { const int e = r / GU_IT; r %= GU_IT; p.W = a.in[12] + (size_t)(l * 32 + e) * 1024 * 2048; p.N = 2048; p.WT = (bf16_t*)(ws + WS_WGU + (size_t)(l * 32 + e) * 2048 * 1024); p.mode = 1; }
    else { r -= 32 * GU_IT; const int e = r / DN_IT; r %= DN_IT; p.W = a.in[14] + (size_t)(l * 32 + e) * 1024 * 1024; p.N = 1024; p.WT = (bf16_t*)(ws + WS_WDN + (size_t)(l * 32 + e) * 1024 * 1024); p.mode = 2; }
    const int nblk = p.N / 64; p.k0 = (r / nblk) * 64; p.n0 = (r % nblk) * 64;
    return p;
}
__device__ __forceinline__ void phase_prologue(const Args& a, LAS unsigned char* lds, const int tid) {
    const int lane = tid & 63, wave = __builtin_amdgcn_readfirstlane(tid >> 6), G = gridDim.x;
    const int gw = blockIdx.x * 8 + wave, NGW = G * 8; const int gt = blockIdx.x * 512 + tid, NGT = G * 512;
    unsigned char* ws = a.ws;
    if (gt < 64) ((int*)(ws + WS_CTL))[gt] = 0;
    if (gt < 24) ((float*)(ws + WS_CTL + 1024))[gt] = 0.f;
    for (int i = gt; i < 2 * INWP; i += NGT) { const int l = i / INWP, c = i % INWP; ((float*)(ws + WS_BPAD))[i] = c < INW ? a.in[2][l * INW + c] : 0.f; }
    { unsigned zu = 0u; asm volatile("" : "+v"(zu));
      for (int i = gt; i < 2 * 16 * 128 * 8; i += NGT) { const int l = i / (16 * 128 * 8), kt = (i / (128 * 8)) & 15, r = 128 + ((i >> 3) & 127), pc = i & 7;
        *(u32x4*)(ws + WS_WIN + (size_t)l * INWP * 2048 + (size_t)11 * (256 * 2048) + (size_t)kt * 32768 + (size_t)r * 128 + pc * 16) = (u32x4){zu, zu, zu, zu}; } }
    for (int i = gt; i < 2 * 4 * 4096; i += NGT) { const int lg = i >> 12, d = (i >> 6) & 63, c = i & 63; const float v = a.in[3][(size_t)lg * 4096 + c * 64 + d]; ((bf16_t*)(ws + WS_POOLW))[i] = (bf16_t)(pk2(v, v) & 0xffff); }
    for (int i = gt; i < 16384 * 32; i += NGT) { const int pos = i >> 5, f = i & 31;
        double invd = 1.0; for (int j = 0; j < f; ++j) invd *= 0.7498942093324559;
        const float inv = (float)invd;
        const float ang = (float)pos * inv;
        const double rev = (double)ang * 0.15915494309189535; const float fr = (float)(rev - rint(rev));
        ((float*)(ws + WS_ROT))[i] = __builtin_amdgcn_cosf(fr); ((float*)(ws + WS_ROT))[16384 * 32 + i] = __builtin_amdgcn_sinf(fr); }
    { const f32x4* x4 = (const f32x4*)a.in[0]; u32x2* o = (u32x2*)(ws + WS_XB);
      for (int i = gt; i < NTOK * 1024 / 4; i += NGT) { const f32x4 v = x4[i]; u32x2 w; w.x = pk2(v[0], v[1]); w.y = pk2(v[2], v[3]); o[i] = w; } }
    LAS float* scr = (LAS float*)(lds + wave * 16640);
    constexpr int NIT = 2 * (16 * 46 + 256 + 32 * 512 + 32 * 256);
    float v[64];
    int it = gw;
    if (it < NIT) { const P0Item p = p0_decode(a, it); const float* src = p.W + (size_t)p.k0 * p.N + p.n0 + lane;
#pragma unroll
        for (int i = 0; i < 64; ++i) v[i] = src[(size_t)i * p.N]; }
    for (; it < NIT; it += NGW) {
        const P0Item p = p0_decode(a, it);
#pragma unroll
        for (int i = 0; i < 64; ++i) scr[i * 65 + lane] = v[i];
        lds_fence();
        if (it + NGW < NIT) { const P0Item pn = p0_decode(a, it + NGW); const float* src = pn.W + (size_t)pn.k0 * pn.N + pn.n0 + lane;
#pragma unroll
            for (int i = 0; i < 64; ++i) v[i] = src[(size_t)i * pn.N]; }
        const int c = lane & 7;
#pragma unroll
        for (int j = 0; j < 8; ++j) { const int nl = (lane >> 3) + 8 * j; const LAS float* sp = scr + (8 * c) * 65 + nl;
            const int n = p.n0 + nl; int dest = n;
            if (p.mode == 1) { const int jj = n & 1023; dest = ((jj >> 4) << 5) + (jj & 15) + ((n >> 10) << 4); }
            const size_t tl = (size_t)(dest >> 8), rr = (size_t)(dest & 255);
            if (p.mode == 0) { u32x4 o; o.x = pk2(sp[0], sp[65]); o.y = pk2(sp[2 * 65], sp[3 * 65]); o.z = pk2(sp[4 * 65], sp[5 * 65]); o.w = pk2(sp[6 * 65], sp[7 * 65]);
                *(u32x4*)((unsigned char*)p.WT + tl * (256 * 2048) + (size_t)(p.k0 >> 6) * 32768 + rr * 128 + 16 * c) = o; }
            else { u32x2 o; o.x = pk4_fp8(sp[0] * W8_SCALE, sp[65] * W8_SCALE, sp[2 * 65] * W8_SCALE, sp[3 * 65] * W8_SCALE); o.y = pk4_fp8(sp[4 * 65] * W8_SCALE, sp[5 * 65] * W8_SCALE, sp[6 * 65] * W8_SCALE, sp[7 * 65] * W8_SCALE);
                *(u32x2*)((unsigned char*)p.WT + tl * (256 * 1024) + (size_t)(p.k0 >> 7) * 32768 + rr * 128 + (p.k0 & 127) + 8 * c) = o; } }
        lds_fence();
    }
}

constexpr int TLD = 72;
constexpr int TLDA = 68;
template <bool SCALE>
__device__ __forceinline__ void load_tile_T(const bf16_t* src, LAS bf16_t* T, int lane, float sc0, float scmul) {
    const int cr = lane >> 3, dc = lane & 7;
    u32x4 v[8];
#pragma unroll
    for (int i = 0; i < 8; ++i) v[i] = *(const u32x4*)(src + (size_t)(cr + 8 * i) * INWP + 8 * dc);
#pragma unroll
    for (int i = 0; i < 8; ++i) { const int row = cr + 8 * i; u32x4 w = v[i];
        if (SCALE) { const float s = sc0 * __builtin_amdgcn_exp2f(scmul * (float)row);
            w.x = pk2(bflo(w.x) * s, bfhi(w.x) * s); w.y = pk2(bflo(w.y) * s, bfhi(w.y) * s); w.z = pk2(bflo(w.z) * s, bfhi(w.z) * s); w.w = pk2(bflo(w.w) * s, bfhi(w.w) * s); }
        LAS bf16_t* t = T + (8 * dc) * TLD + row;
        t[0 * TLD] = (bf16_t)(w.x & 0xffff); t[1 * TLD] = (bf16_t)(w.x >> 16); t[2 * TLD] = (bf16_t)(w.y & 0xffff); t[3 * TLD] = (bf16_t)(w.y >> 16);
        t[4 * TLD] = (bf16_t)(w.z & 0xffff); t[5 * TLD] = (bf16_t)(w.z >> 16); t[6 * TLD] = (bf16_t)(w.w & 0xffff); t[7 * TLD] = (bf16_t)(w.w >> 16); }
}
__device__ __forceinline__ float log2_gamma(int h) { return log2f(1.0f - exp2f(-5.0f - (float)h)); }

__device__ __forceinline__ void rot8(u32x4 x1, u32x4 x2, const float* cs, const float* sn, float sc, u32x4& o1, u32x4& o2) {
    const f32x4 c0 = *(const f32x4*)cs, c1 = *(const f32x4*)(cs + 4), s0 = *(const f32x4*)sn, s1 = *(const f32x4*)(sn + 4);
    float a[8], b[8], c[8], s[8];
    a[0] = bflo(x1.x); a[1] = bfhi(x1.x); a[2] = bflo(x1.y); a[3] = bfhi(x1.y); a[4] = bflo(x1.z); a[5] = bfhi(x1.z); a[6] = bflo(x1.w); a[7] = bfhi(x1.w);
    b[0] = bflo(x2.x); b[1] = bfhi(x2.x); b[2] = bflo(x2.y); b[3] = bfhi(x2.y); b[4] = bflo(x2.z); b[5] = bfhi(x2.z); b[6] = bflo(x2.w); b[7] = bfhi(x2.w);
#pragma unroll
    for (int i = 0; i < 4; ++i) { c[i] = c0[i]; c[4 + i] = c1[i]; s[i] = s0[i]; s[4 + i] = s1[i]; }
    float p[8], q[8];
#pragma unroll
    for (int i = 0; i < 8; ++i) { p[i] = (a[i] * c[i] - b[i] * s[i]) * sc; q[i] = (a[i] * s[i] + b[i] * c[i]) * sc; }
    o1.x = pk2(p[0], p[1]); o1.y = pk2(p[2], p[3]); o1.z = pk2(p[4], p[5]); o1.w = pk2(p[6], p[7]);
    o2.x = pk2(q[0], q[1]); o2.y = pk2(q[2], q[3]); o2.z = pk2(q[4], q[5]); o2.w = pk2(q[6], q[7]);
}

__device__ __forceinline__ void pool_item(const bf16_t* hbuf, const bf16_t* pwT, const float* pscale, bf16_t* mixed, int item, int lane) {
    const int k = item >> 11, gwi = item & 2047, g = (gwi + k) & 3, tile = (gwi >> 2) * 4 + k, t0 = tile * 16, w = 2 << g;
    const int r = lane & 15, q = lane >> 4, t = t0 + r, ts = t % SEQ;
    const bf16_t* up = hbuf + (size_t)t * INWP + g * 64 + 8 * q;
    bf16x8 pf[2];
#pragma unroll
    for (int ks = 0; ks < 2; ++ks) { float s[8], u0[8];
#pragma unroll
        for (int e = 0; e < 8; ++e) s[e] = 0.f;
        for (int i = 0; i < w; ++i) { if (ts - i >= 0) { const u32x4 v = *(const u32x4*)(up - (size_t)i * INWP + 32 * ks);
            const float f[8] = {bflo(v.x), bfhi(v.x), bflo(v.y), bfhi(v.y), bflo(v.z), bfhi(v.z), bflo(v.w), bfhi(v.w)};
#pragma unroll
            for (int e = 0; e < 8; ++e) { s[e] += f[e]; if (i == 0) u0[e] = f[e]; } } }
        const float cnt = (float)min(ts + 1, w); float o[8];
#pragma unroll
        for (int e = 0; e < 8; ++e) o[e] = s[e] / cnt - u0[e];
        pf[ks] = as_bf16x8((u32x4){pk2(o[0], o[1]), pk2(o[2], o[3]), pk2(o[4], o[5]), pk2(o[6], o[7])}); }
#pragma unroll
    for (int dt = 0; dt < 4; ++dt) { f32x4 acc = {0.f, 0.f, 0.f, 0.f};
#pragma unroll
        for (int ks = 0; ks < 2; ++ks) { const bf16x8 wf = as_bf16x8(*(const u32x4*)(pwT + (g * 64 + 16 * dt + r) * 64 + 32 * ks + 8 * q)); acc = __builtin_amdgcn_mfma_f32_16x16x32_bf16(wf, pf[ks], acc, 0, 0, 0); }
        const int d = g * 64 + 16 * dt + 4 * q; const f32x4 sc = *(const f32x4*)(pscale + d);
        u32x2 o; o.x = pk2(acc[0] * sc[0], acc[1] * sc[1]); o.y = pk2(acc[2] * sc[2], acc[3] * sc[3]);
        *(u32x2*)(mixed + (size_t)t * 1024 + d) = o; }
}

__device__ __forceinline__ void retkv_item(const bf16_t* hbuf, const float* rot, float* kvbuf, LAS bf16_t* wl, int item, int lane) {
    const int bh = item / NCHUNK, n = item % NCHUNK, b = bh / 6, h = bh % 6; const size_t t0 = (size_t)b * SEQ + (size_t)n * 64;
    LAS bf16_t* kT = wl; LAS bf16_t* vT = wl + 64 * TLD;
    const float l2g = log2_gamma(h);
    load_tile_T<true>(hbuf + t0 * INWP + C_RV + h * 64, vT, lane, exp2f(l2g * 63.f), -l2g);
    { const int cr = lane >> 3, dc = lane & 7, fc = dc & 3;
#pragma unroll
      for (int i = 0; i < 8; ++i) { const int row = cr + 8 * i; const bf16_t* kp = hbuf + (t0 + row) * INWP + C_RK + h * 64;
          const u32x4 x1 = *(const u32x4*)(kp + 8 * fc), x2 = *(const u32x4*)(kp + 32 + 8 * fc);
          const int pos = n * 64 + row; u32x4 o1, o2;
          rot8(x1, x2, rot + (size_t)pos * 32 + 8 * fc, rot + 16384 * 32 + (size_t)pos * 32 + 8 * fc, 0.125f, o1, o2);
          const u32x4 w = dc < 4 ? o1 : o2;
          LAS bf16_t* t = kT + (8 * dc) * TLD + row;
          t[0 * TLD] = (bf16_t)(w.x & 0xffff); t[1 * TLD] = (bf16_t)(w.x >> 16); t[2 * TLD] = (bf16_t)(w.y & 0xffff); t[3 * TLD] = (bf16_t)(w.y >> 16);
          t[4 * TLD] = (bf16_t)(w.z & 0xffff); t[5 * TLD] = (bf16_t)(w.z >> 16); t[6 * TLD] = (bf16_t)(w.w & 0xffff); t[7 * TLD] = (bf16_t)(w.w >> 16); } }
    lds_fence();
    const int r = lane & 15, q = lane >> 4;
    float* outp = kvbuf + (size_t)item * 4096;
#pragma unroll
    for (int et = 0; et < 4; ++et) {
        bf16x8 vf[2];
#pragma unroll
        for (int ks = 0; ks < 2; ++ks) vf[ks] = *(const LAS bf16x8*)(vT + (16 * et + r) * TLD + 32 * ks + 8 * q);
#pragma unroll
        for (int dt = 0; dt < 4; ++dt) { f32x4 acc = {0.f, 0.f, 0.f, 0.f};
#pragma unroll
            for (int ks = 0; ks < 2; ++ks) { const bf16x8 kf = *(const LAS bf16x8*)(kT + (16 * dt + r) * TLD + 32 * ks + 8 * q);
                acc = __builtin_amdgcn_mfma_f32_16x16x32_bf16(kf, vf[ks], acc, 0, 0, 0); }
            *(f32x4*)(outp + (16 * et + r) * 64 + 16 * dt + 4 * q) = acc; } }
    lds_fence();
}
__device__ __forceinline__ void knorm_item(const bf16_t* hbuf, float* kmax2, int item, int lane) {
    const int bh = item / NCHUNK, n = item % NCHUNK, b = bh / 6, h = bh % 6; const size_t t0 = (size_t)b * SEQ + (size_t)n * 64;
    const int cr = lane >> 3, dc = lane & 7; float mx = 0.f;
#pragma unroll
    for (int i = 0; i < 8; ++i) { const u32x4 v = *(const u32x4*)(hbuf + (t0 + cr + 8 * i) * INWP + C_SBK + h * 64 + 8 * dc);
        float s = bflo(v.x) * bflo(v.x) + bfhi(v.x) * bfhi(v.x) + bflo(v.y) * bflo(v.y) + bfhi(v.y) * bfhi(v.y) + bflo(v.z) * bflo(v.z) + bfhi(v.z) * bfhi(v.z) + bflo(v.w) * bflo(v.w) + bfhi(v.w) * bfhi(v.w);
        s += sx(s, 1, lane); s += sx(s, 2, lane); s += sx(s, 4, lane); mx = fmaxf(mx, s); }
    mx = fmaxf(mx, sx(mx, 8, lane)); mx = fmaxf(mx, sx(mx, 16, lane)); mx = fmaxf(mx, sx(mx, 32, lane));
    if (lane == 0) atomicMax((unsigned*)kmax2 + bh, __float_as_uint(mx));
}

__device__ __forceinline__ bf16x8 pack_tiles(const f32x4& t0, const f32x4& t1) { u32x4 w; w.x = pk2(t0[0], t0[1]); w.y = pk2(t0[2], t0[3]); w.z = pk2(t1[0], t1[1]); w.w = pk2(t1[2], t1[3]); return as_bf16x8(w); }
template <int P = TLD>
__device__ __forceinline__ bf16x8 vt_frag(const LAS bf16_t* vT, int et, int mb, int r, int q) {
    const LAS bf16_t* p = vT + (16 * et + r) * P + 32 * mb + 4 * q; const u32x2 a = *(const LAS u32x2*)p, b = *(const LAS u32x2*)(p + 16);
    return as_bf16x8((u32x4){a.x, a.y, b.x, b.y});
}

__device__ __forceinline__ void sb_item(const bf16_t* hbuf, const float* kmax2, bf16_t* mixed, LAS bf16_t* vT, int item, int lane) {
    const int bh = item >> 10, qt = item & 1023, b = bh / 6, h = bh % 6, tq0 = qt * 16; const size_t row0 = (size_t)b * SEQ + tq0;
    const int r = lane & 15, q = lane >> 4;
    bf16x8 qf[2]; float bound, carry = 0.f;
    const float km2 = kmax2[bh];
    { float s = 0.f;
#pragma unroll
      for (int ks = 0; ks < 2; ++ks) { const u32x4 v = *(const u32x4*)(hbuf + (row0 + r) * INWP + C_SBQ + h * 64 + 32 * ks + 8 * q); qf[ks] = as_bf16x8(v);
          s += bflo(v.x) * bflo(v.x) + bfhi(v.x) * bfhi(v.x) + bflo(v.y) * bflo(v.y) + bfhi(v.y) * bfhi(v.y) + bflo(v.z) * bflo(v.z) + bfhi(v.z) * bfhi(v.z) + bflo(v.w) * bflo(v.w) + bfhi(v.w) * bfhi(v.w); }
      s += sx(s, 16, lane); s += sx(s, 32, lane);
      bound = sqrtf(s * km2) * 0.125f * 1.01f + 0.05f; }
    const int qpos = tq0 + r;
    f32x4 O[4];
#pragma unroll
    for (int et = 0; et < 4; ++et) O[et] = (f32x4){0.f, 0.f, 0.f, 0.f};
    const int cr = lane >> 3, dc = lane & 7;
    const bf16_t* seqp = hbuf + (size_t)b * SEQ * INWP + h * 64;
    u32x4 vreg[8], kreg[8];
    { const int k0 = tq0 + 16 - 64;
#pragma unroll
      for (int i = 0; i < 8; ++i) vreg[i] = *(const u32x4*)(seqp + (size_t)max(k0 + cr + 8 * i, 0) * INWP + C_SBV + 8 * dc);
#pragma unroll
      for (int i = 0; i < 8; ++i) kreg[i] = *(const u32x4*)(seqp + (size_t)max(k0 + 16 * (i >> 1) + r, 0) * INWP + C_SBK + 32 * (i & 1) + 8 * q); }
    for (int k0 = tq0 + 16 - 64; k0 > -64; k0 -= 64) {
#pragma unroll
        for (int i = 0; i < 8; ++i) { const int row = cr + 8 * i; const u32x4 w = vreg[i]; LAS bf16_t* t = vT + (8 * dc) * TLDA + row;
            t[0 * TLDA] = (bf16_t)(w.x & 0xffff); t[1 * TLDA] = (bf16_t)(w.x >> 16); t[2 * TLDA] = (bf16_t)(w.y & 0xffff); t[3 * TLDA] = (bf16_t)(w.y >> 16);
            t[4 * TLDA] = (bf16_t)(w.z & 0xffff); t[5 * TLDA] = (bf16_t)(w.z >> 16); t[6 * TLDA] = (bf16_t)(w.w & 0xffff); t[7 * TLDA] = (bf16_t)(w.w >> 16); }
        f32x4 z[4], lk[4];
#pragma unroll
        for (int mt = 0; mt < 4; ++mt) { f32x4 acc = {0.f, 0.f, 0.f, 0.f};
#pragma unroll
            for (int ks = 0; ks < 2; ++ks) acc = __builtin_amdgcn_mfma_f32_16x16x32_bf16(as_bf16x8(kreg[2 * mt + ks]), qf[ks], acc, 0, 0, 0);
            z[mt] = acc; }
        if (k0 > 0) { const int kn0 = k0 - 64;
#pragma unroll
            for (int i = 0; i < 8; ++i) vreg[i] = *(const u32x4*)(seqp + (size_t)max(kn0 + cr + 8 * i, 0) * INWP + C_SBV + 8 * dc);
#pragma unroll
            for (int i = 0; i < 8; ++i) kreg[i] = *(const u32x4*)(seqp + (size_t)max(kn0 + 16 * (i >> 1) + r, 0) * INWP + C_SBK + 32 * (i & 1) + 8 * q); }
#pragma unroll
        for (int mt = 0; mt < 4; ++mt) {
            z[mt] = z[mt] * 0.125f;
#pragma unroll
            for (int j = 0; j < 4; ++j) { const int kp = k0 + 16 * mt + 4 * q + j; const bool valid = (kp < qpos) && (kp >= 0); const float zz = z[mt][j];
                lk[mt][j] = valid ? -(fmaxf(zz, 0.f) + __logf(1.0f + __expf(-fabsf(zz)))) : 0.f; } }
        bf16x8 lh[2], ll[2];
#pragma unroll
        for (int mb = 0; mb < 2; ++mb) { lh[mb] = pack_tiles(lk[2 * mb], lk[2 * mb + 1]);
            const u32x4 hw = __builtin_bit_cast(u32x4, lh[mb]); f32x4 d0, d1;
            d0[0] = lk[2 * mb][0] - bflo(hw.x); d0[1] = lk[2 * mb][1] - bfhi(hw.x); d0[2] = lk[2 * mb][2] - bflo(hw.y); d0[3] = lk[2 * mb][3] - bfhi(hw.y);
            d1[0] = lk[2 * mb + 1][0] - bflo(hw.z); d1[1] = lk[2 * mb + 1][1] - bfhi(hw.z); d1[2] = lk[2 * mb + 1][2] - bflo(hw.w); d1[3] = lk[2 * mb + 1][3] - bfhi(hw.w);
            ll[mb] = pack_tiles(d0, d1); }
        f32x4 rs[4];
#pragma unroll
        for (int mt = 0; mt < 4; ++mt) { f32x4 acc = {0.f, 0.f, 0.f, 0.f};
#pragma unroll
            for (int mb = 0; mb < 2; ++mb) {
                const int m = 16 * mt + r; unsigned tw[4];
#pragma unroll
                for (int p = 0; p < 4; ++p) { const int i0 = 2 * p, i1 = 2 * p + 1;
                    const int ma = 32 * mb + (i0 < 4 ? 4 * q + i0 : 16 + 4 * q + i0 - 4), mbb = 32 * mb + (i1 < 4 ? 4 * q + i1 : 16 + 4 * q + i1 - 4);
                    tw[p] = (ma >= m ? 0x3f80u : 0u) | (mbb >= m ? 0x3f800000u : 0u); }
                const bf16x8 tri = as_bf16x8((u32x4){tw[0], tw[1], tw[2], tw[3]});
                acc = __builtin_amdgcn_mfma_f32_16x16x32_bf16(tri, lh[mb], acc, 0, 0, 0);
                acc = __builtin_amdgcn_mfma_f32_16x16x32_bf16(tri, ll[mb], acc, 0, 0, 0); }
            rs[mt] = acc; }
        const float total = sl(rs[0][0], r);
        bf16x8 af[2];
        { f32x4 av[4];
#pragma unroll
          for (int mt = 0; mt < 4; ++mt)
#pragma unroll
              for (int j = 0; j < 4; ++j) { const int kp = k0 + 16 * mt + 4 * q + j; const bool valid = (kp < qpos) && (kp >= 0); av[mt][j] = valid ? __expf(z[mt][j] + rs[mt][j] + carry) : 0.f; }
          af[0] = pack_tiles(av[0], av[1]); af[1] = pack_tiles(av[2], av[3]); }
        lds_fence();
#pragma unroll
        for (int et = 0; et < 4; ++et)
#pragma unroll
            for (int mb = 0; mb < 2; ++mb) O[et] = __builtin_amdgcn_mfma_f32_16x16x32_bf16(vt_frag<TLDA>(vT, et, mb, r, q), af[mb], O[et], 0, 0, 0);
        carry += total;
        lds_fence();
        if (__all(carry + bound < -105.f)) break;
    }
#pragma unroll
    for (int et = 0; et < 4; ++et) { u32x2 w; w.x = pk2(O[et][0], O[et][1]); w.y = pk2(O[et][2], O[et][3]);
        *(u32x2*)(mixed + (row0 + r) * 1024 + M_SB + h * 64 + 16 * et + 4 * q) = w; }
}

__device__ __forceinline__ void retout_item(const bf16_t* hbuf, const float* rot, const float* kvbuf, const float* normg, bf16_t* mixed, LAS bf16_t* vT, int item, int lane) {
    const int bh = item / NCHUNK, n = item % NCHUNK, b = bh / 6, h = bh % 6; const size_t t0 = (size_t)b * SEQ + (size_t)n * 64;
    const int r = lane & 15, q = lane >> 4; const float l2g = log2_gamma(h);
    load_tile_T<false>(hbuf + t0 * INWP + C_RV + h * 64, vT, lane, 0.f, 0.f);
    const float* cs = rot; const float* sn = rot + 16384 * 32;
    bf16x8 kf[4][2]; LAS bf16_t* RT = vT + 64 * TLD;
#pragma unroll
    for (int mt = 0; mt < 4; ++mt) { const int row = 16 * mt + r; const bf16_t* kp = hbuf + (t0 + row) * INWP + C_RK + h * 64 + 8 * q; const int pos = n * 64 + row; u32x4 o1, o2;
        rot8(*(const u32x4*)kp, *(const u32x4*)(kp + 32), cs + (size_t)pos * 32 + 8 * q, sn + (size_t)pos * 32 + 8 * q, 0.125f, o1, o2); kf[mt][0] = as_bf16x8(o1); kf[mt][1] = as_bf16x8(o2); }
    const float* Rp = kvbuf + (size_t)item * 4096;
#pragma unroll
    for (int et = 0; et < 4; ++et)
#pragma unroll
        for (int ks = 0; ks < 2; ++ks) { const float* p = Rp + (16 * et + r) * 64 + 32 * ks + 8 * q; const f32x4 a = *(const f32x4*)p, c = *(const f32x4*)(p + 4);
            *(LAS u32x4*)(RT + (16 * et + r) * TLD + 32 * ks + 8 * q) = (u32x4){pk2(a[0], a[1]), pk2(a[2], a[3]), pk2(c[0], c[1]), pk2(c[2], c[3])}; }
    lds_fence();
#pragma unroll 1
    for (int ct = 0; ct < 4; ++ct) {
        const int c = 16 * ct + r; const bf16_t* qp = hbuf + (t0 + c) * INWP + C_RQ + h * 64 + 8 * q; const int pos = n * 64 + c; u32x4 o1, o2;
        rot8(*(const u32x4*)qp, *(const u32x4*)(qp + 32), cs + (size_t)pos * 32 + 8 * q, sn + (size_t)pos * 32 + 8 * q, 1.0f, o1, o2);
        const bf16x8 q0 = as_bf16x8(o1), q1 = as_bf16x8(o2);
        f32x4 OT[4];
        const float xi = __builtin_amdgcn_exp2f(l2g * (float)(c + 1));
#pragma unroll
        for (int et = 0; et < 4; ++et) { f32x4 acc = {0.f, 0.f, 0.f, 0.f};
            const bf16x8 R0 = *(const LAS bf16x8*)(RT + (16 * et + r) * TLD + 8 * q), R1 = *(const LAS bf16x8*)(RT + (16 * et + r) * TLD + 32 + 8 * q);
            acc = __builtin_amdgcn_mfma_f32_16x16x32_bf16(R0, q0, acc, 0, 0, 0); acc = __builtin_amdgcn_mfma_f32_16x16x32_bf16(R1, q1, acc, 0, 0, 0);
            OT[et] = acc * xi; }
        f32x4 st[4];
#pragma unroll
        for (int mt = 0; mt < 4; ++mt) { f32x4 acc = {0.f, 0.f, 0.f, 0.f};
            acc = __builtin_amdgcn_mfma_f32_16x16x32_bf16(kf[mt][0], q0, acc, 0, 0, 0); acc = __builtin_amdgcn_mfma_f32_16x16x32_bf16(kf[mt][1], q1, acc, 0, 0, 0);
#pragma unroll
            for (int j = 0; j < 4; ++j) { const int m = 16 * mt + 4 * q + j; const int dd = c > m ? c - m : m - c; acc[j] *= __builtin_amdgcn_exp2f(l2g * (float)dd); }
            st[mt] = acc; }
        const bf16x8 p0 = pack_tiles(st[0], st[1]), p1 = pack_tiles(st[2], st[3]);
#pragma unroll
        for (int et = 0; et < 4; ++et) { OT[et] = __builtin_amdgcn_mfma_f32_16x16x32_bf16(vt_frag(vT, et, 0, r, q), p0, OT[et], 0, 0, 0);
            OT[et] = __builtin_amdgcn_mfma_f32_16x16x32_bf16(vt_frag(vT, et, 1, r, q), p1, OT[et], 0, 0, 0); }
        float s = 0.f;
#pragma unroll
        for (int et = 0; et < 4; ++et) s += (OT[et][0] + OT[et][1]) + (OT[et][2] + OT[et][3]);
        s += sx(s, 16, lane); s += sx(s, 32, lane);
        const float mu = s * (1.0f / 64.0f); float v = 0.f;
#pragma unroll
        for (int et = 0; et < 4; ++et)
#pragma unroll
            for (int j = 0; j < 4; ++j) { const float d = OT[et][j] - mu; v += d * d; }
        v += sx(v, 16, lane); v += sx(v, 32, lane);
        const float rstd = rsqrtf(v * (1.0f / 64.0f) + LN_EPS);
#pragma unroll
        for (int et = 0; et < 4; ++et) { const int e = 16 * et + 4 * q;
            const u32x2 gw = *(const u32x2*)(hbuf + (t0 + c) * INWP + C_RG + h * 64 + e); const f32x4 ng = *(const f32x4*)(normg + h * 64 + e);
            float gt[4] = {bflo(gw.x), bfhi(gw.x), bflo(gw.y), bfhi(gw.y)}, o[4];
#pragma unroll
            for (int j = 0; j < 4; ++j) { const float sl = gt[j] * __builtin_amdgcn_rcpf(1.0f + __expf(-gt[j])); o[j] = (OT[et][j] - mu) * rstd * ng[j] * sl; }
            u32x2 w; w.x = pk2(o[0], o[1]); w.y = pk2(o[2], o[3]);
            *(u32x2*)(mixed + (t0 + c) * 1024 + M_RET + h * 64 + e) = w; }
    }
    lds_fence();
}

__device__ __forceinline__ void ln1_router_phase(const Args& a, int l, LAS unsigned char* lds, const int tid, const int rpt) {
    const int lane = tid & 63, wave = __builtin_amdgcn_readfirstlane(tid >> 6);
    unsigned char* ws = a.ws;
    const bf16_t* ypre = (const bf16_t*)(ws + WS_YPRE); bf16_t* x1b = (bf16_t*)(ws + WS_X1B); unsigned char* x1q = ws + WS_X1Q;
    const float* g1 = a.in[8] + l * 1024; const float* b1 = a.in[9] + l * 1024; const float* rw = a.in[10] + (size_t)l * 1024 * 32; const float* rb = a.in[11] + l * 32;
    int* cnt = (int*)(ws + WS_CTL) + l * 32; int* slot_e = (int*)(ws + WS_SLOTE); int* slot_pos = (int*)(ws + WS_SLOTPOS); float* slot_g = (float*)(ws + WS_SLOTG);
    LAS float* X = (LAS float*)lds; LAS float* PART = X + 16 * 1028; LAS float* LG = PART + 8 * 512;
    LAS int* LCNT = (LAS int*)(LG + 512); LAS int* LBASE = LCNT + 32; LAS int* LSLOT = LBASE + 32; constexpr int MAXLOC = 16; LAS float* TV = (LAS float*)(LSLOT + MAXLOC * 64);
    if (tid < 32) LCNT[tid] = 0;
    __syncthreads();
    int iloc = 0;
    f32x4 gv[4], bv[4];
#pragma unroll
    for (int j = 0; j < 4; ++j) { gv[j] = *(const f32x4*)(g1 + 4 * (64 * j + lane)); bv[j] = *(const f32x4*)(b1 + 4 * (64 * j + lane)); }
    const int r16 = lane & 15, kq = lane >> 4, kb = wave * 128;
    float w0[32], w1[32];
#pragma unroll
    for (int ks = 0; ks < 32; ++ks) { const int k = kb + 4 * ks + kq; w0[ks] = rw[k * 32 + r16]; w1[ks] = rw[k * 32 + 16 + r16]; }
    u32x2 pre[2][4];
    { const int t0 = blockIdx.x;
      if (t0 < NTOK / 16) {
#pragma unroll
        for (int rr = 0; rr < 2; ++rr)
#pragma unroll
            for (int j = 0; j < 4; ++j) pre[rr][j] = *(const u32x2*)(ypre + (size_t)(t0 * 16 + 2 * wave + rr) * 1024 + 4 * (64 * j + lane)); } }
    for (int tile = blockIdx.x; tile < NTOK / 16; tile += gridDim.x) {
        const int tok0 = tile * 16;
#pragma unroll
        for (int rr = 0; rr < 2; ++rr) { const int lr = 2 * wave + rr;
            f32x4 v[4]; float s = 0.f;
#pragma unroll
            for (int j = 0; j < 4; ++j) { const u32x2 w = pre[rr][j]; v[j] = (f32x4){bflo(w.x), bfhi(w.x), bflo(w.y), bfhi(w.y)}; s += (v[j][0] + v[j][1]) + (v[j][2] + v[j][3]); }
            const float mean = wave_sum(s, lane) * (1.f / 1024.f); float s2 = 0.f;
#pragma unroll
            for (int j = 0; j < 4; ++j) { v[j] = v[j] - mean; s2 += (v[j][0] * v[j][0] + v[j][1] * v[j][1]) + (v[j][2] * v[j][2] + v[j][3] * v[j][3]); }
            const float rstd = rsqrtf(wave_sum(s2, lane) * (1.f / 1024.f) + LN_EPS);
#pragma unroll
            for (int j = 0; j < 4; ++j) { const f32x4 y = v[j] * rstd * gv[j] + bv[j];
                u32x2 w; w.x = pk2(y[0], y[1]); w.y = pk2(y[2], y[3]); *(u32x2*)(x1b + (size_t)(tok0 + lr) * 1024 + 4 * (64 * j + lane)) = w;
                *(unsigned*)(x1q + (size_t)(tok0 + lr) * 1024 + 4 * (64 * j + lane)) = pk4_fp8(y[0], y[1], y[2], y[3]);
                *(LAS f32x4*)(X + lr * 1028 + 4 * (64 * j + lane)) = y; } }
        __syncthreads();
        { const int nt = tile + gridDim.x;
          if (nt < NTOK / 16) {
#pragma unroll
            for (int rr = 0; rr < 2; ++rr)
#pragma unroll
                for (int j = 0; j < 4; ++j) pre[rr][j] = *(const u32x2*)(ypre + (size_t)(nt * 16 + 2 * wave + rr) * 1024 + 4 * (64 * j + lane)); } }
        { f32x4 acc0 = {0.f, 0.f, 0.f, 0.f}, acc1 = {0.f, 0.f, 0.f, 0.f};
#pragma unroll
          for (int ks = 0; ks < 32; ++ks) { const float av = X[r16 * 1028 + kb + 4 * ks + kq];
              acc0 = __builtin_amdgcn_mfma_f32_16x16x4f32(av, w0[ks], acc0, 0, 0, 0); acc1 = __builtin_amdgcn_mfma_f32_16x16x4f32(av, w1[ks], acc1, 0, 0, 0); }
#pragma unroll
          for (int j = 0; j < 4; ++j) { PART[wave * 512 + (4 * kq + j) * 32 + r16] = acc0[j]; PART[wave * 512 + (4 * kq + j) * 32 + 16 + r16] = acc1[j]; } }
        __syncthreads();
        { float s = rb[tid & 31];
#pragma unroll
          for (int w = 0; w < 8; ++w) s += PART[w * 512 + tid];
          LG[tid] = s; }
        __syncthreads();
        { const int t = tid >> 5, e = tid & 31; const float v = LG[tid]; int rank = 0;
#pragma unroll 8
          for (int j = 0; j < 32; ++j) { const float o = LG[t * 32 + j]; rank += (o > v || (o == v && j < e)) ? 1 : 0; }
          const bool sel = rank < 4;
          if (sel) TV[t * 4 + rank] = v;
          lds_fence();
          if (sel) { const float m = TV[t * 4], den = ((__expf(TV[t * 4] - m) + __expf(TV[t * 4 + 1] - m)) + __expf(TV[t * 4 + 2] - m)) + __expf(TV[t * 4 + 3] - m);
              const float gate = __expf(v - m) * (1.0f / den); const int tok = tok0 + t, k = rank;
              if (rpt == 0) { const int s = tok * 4 + k; slot_e[s] = e; slot_g[s] = gate;
                  if (iloc < MAXLOC) { const int lpos = atomicAdd((int*)&LCNT[e], 1); LSLOT[iloc * 64 + t * 4 + k] = (e << 16) | lpos; }
                  else { const int pos = atomicAdd(cnt + e, 1); slot_pos[s] = pos; } } }
          lds_fence(); }
        ++iloc;
    }
    __syncthreads();
    if (rpt == 0) {
        if (tid < 32) LBASE[tid] = atomicAdd(cnt + tid, LCNT[tid]);
        __syncthreads();
        const int nl = (iloc < MAXLOC ? iloc : MAXLOC) * 64;
        for (int j = tid; j < nl; j += 512) { const int v = LSLOT[j], e = v >> 16, lpos = v & 0xffff, i = j >> 6, t = (j >> 2) & 15, k = j & 3;
            slot_pos[(((int)blockIdx.x + i * (int)gridDim.x) * 16 + t) * 4 + k] = LBASE[e] + lpos; }
    }
}

__device__ __forceinline__ void build_tab(const int* cnt, LAS int* TAB, const int tid) {
    if (tid == 0) { int s = 0; for (int e = 0; e < NEXP; ++e) { TAB[e] = s; s += (cnt[e] + 255) >> 8; } TAB[NEXP] = s; }
    __syncthreads();
}

__device__ __forceinline__ void run_phase(const Args& a, const int ph, LAS unsigned char* lds, const int tid, const int rpt) {
    const int lane = tid & 63, wave = __builtin_amdgcn_readfirstlane(tid >> 6), G = gridDim.x;
    const int gw = blockIdx.x * 8 + wave, NGW = G * 8;
    unsigned char* ws = a.ws;
    bf16_t* hbuf = (bf16_t*)(ws + WS_HBUF); bf16_t* mixed = (bf16_t*)(ws + WS_MIXED); float* kvbuf = (float*)(ws + WS_KV);
    const float* rot = (const float*)(ws + WS_ROT);
    LAS int* TAB = (LAS int*)(lds + TAB_OFF);
    {
        if (ph == 0) { phase_prologue(a, lds, tid); }
        else {
            const int l = (ph - 1) / 10, sp = (ph - 1) % 10;
            int* cnt = (int*)(ws + WS_CTL) + l * 32; float* kmax2 = (float*)(ws + WS_CTL + 1024) + l * 12;
            if (sp == 0) {
                pg8::DenseOrder S; S.init(ws + WS_XB, ws + WS_WIN + (size_t)l * INWP * 1024 * 2, NTOK, INWP, 1024, G, blockIdx.x);
                pg8::EpiBf16Bias E{hbuf, INWP, (const float*)(ws + WS_BPAD) + l * INWP};
                pg8::gemm_phase<false, false>(lds, tid, 1024, S, E);
            } else if (sp == 1) {
                for (int it = gw; it < (NTOK / 16) * 4; it += NGW) pool_item(hbuf, (const bf16_t*)(ws + WS_POOLW) + l * 4 * 4096, a.in[4] + l * 256, mixed, it, lane);
                LAS bf16_t* wl = (LAS bf16_t*)(lds + wave * 18432);
                for (int it = gw; it < 12 * NCHUNK; it += NGW) retkv_item(hbuf, rot, kvbuf, wl, it, lane);
                for (int it = gw; it < 12 * NCHUNK; it += NGW) knorm_item(hbuf, kmax2, it, lane);
            } else if (sp == 2) {
                const int nscan = G > 96 ? 96 : G;
                if ((int)blockIdx.x < nscan) {
                    for (int idx = blockIdx.x * 512 + tid; idx < 12 * 4096; idx += nscan * 512) { const int bh = idx >> 12, el = idx & 4095, h = bh % 6;
                        const float g64 = exp2f(64.f * log2_gamma(h)); const float* p = kvbuf + (size_t)bh * NCHUNK * 4096 + el; float* pd = (float*)(ws + WS_RPREV) + (size_t)bh * NCHUNK * 4096 + el; float rr = 0.f;
                        for (int n = 0; n < NCHUNK; n += 32) { float t[32];
#pragma unroll
                            for (int i = 0; i < 32; ++i) t[i] = p[(size_t)(n + i) * 4096];
#pragma unroll
                            for (int i = 0; i < 32; ++i) { pd[(size_t)(n + i) * 4096] = rr; rr = g64 * rr + t[i]; } } }
                }
                { unsigned* qctr = (unsigned*)(ws + WS_BAR) + l * 16;
                  LAS bf16_t* vT = (LAS bf16_t*)(lds + wave * 9216);
                  if (rpt == 0) {
                      const int nstat = (4 * NGW <= 12 * 1024) ? 4 * NGW : 0;
                      if (nstat) for (int it = 4 * gw; it < 4 * gw + 4; ++it) sb_item(hbuf, kmax2, mixed, vT, it, lane);
                      for (;;) { int it0 = 0; if (lane == 0) it0 = (int)atomicAdd(qctr, 2u); it0 = nstat + __builtin_amdgcn_readfirstlane(it0); if (it0 >= 12 * 1024) break;
                          for (int it = it0; it < it0 + 2; ++it) sb_item(hbuf, kmax2, mixed, vT, it, lane); } }
                  else { for (int it = gw; it < 12 * 1024; it += NGW) sb_item(hbuf, kmax2, mixed, vT, it, lane); } }
            } else if (sp == 3) {
                LAS bf16_t* vT = (LAS bf16_t*)(lds + wave * 18432);
                for (int it = gw; it < 12 * NCHUNK; it += NGW) retout_item(hbuf, rot, (const float*)(ws + WS_RPREV), a.in[5] + l * 384, mixed, vT, it, lane);
            } else if (sp == 4) {
                pg8::DenseOrder S; S.init(mixed, ws + WS_WOUT + (size_t)l * 1024 * 1024 * 2, NTOK, 1024, 1024, G, blockIdx.x);
                pg8::EpiResBf16 E{(bf16_t*)(ws + WS_YPRE), (const bf16_t*)(ws + WS_XB), a.in[7] + l * 1024};
                pg8::gemm_phase<false, false>(lds, tid, 1024, S, E);
            } else if (sp == 5) {
                ln1_router_phase(a, l, lds, tid, rpt);
            } else if (sp == 6) {
                build_tab(cnt, TAB, tid);
                const int* slot_e = (const int*)(ws + WS_SLOTE); const int* slot_pos = (const int*)(ws + WS_SLOTPOS); int* rowslot = (int*)(ws + WS_ROWSLOT);
                const float* slot_g = (const float*)(ws + WS_SLOTG); float* rowgate = (float*)(ws + WS_ROWGATE);
                for (int s = blockIdx.x * 512 + tid; s < NTOK * 4; s += G * 512) { const int dest = TAB[slot_e[s]] * 256 + slot_pos[s]; rowslot[dest] = s; rowgate[dest] = slot_g[s]; }
                for (int i = blockIdx.x * 512 + tid; i < NEXP * 256; i += G * 512) { const int e = i >> 8, r = cnt[e] + (i & 255); if (r < ((cnt[e] + 255) & ~255)) { rowslot[TAB[e] * 256 + r] = 0; rowgate[TAB[e] * 256 + r] = 0.f; } }
            } else if (sp == 7) {
                build_tab(cnt, TAB, tid);
                pg8::GroupedOrder S; S.init(ws + WS_X1Q, ws + WS_WGU + (size_t)l * 32 * 2048 * 1024, TAB, 2048, 512, G, blockIdx.x);
                { LAS unsigned short* RT = (LAS unsigned short*)(lds + TAB_OFF + 256); const int* rowslot = (const int*)(ws + WS_ROWSLOT);
                  for (int idx = tid; idx < 31 * 256; idx += 512) { pg8::Unit u; if (S.next(idx >> 8, u)) RT[idx] = (unsigned short)(rowslot[u.pm * 256 + (idx & 255)] >> 2); }
                  __syncthreads(); S.rt = RT; }
                pg8::EpiSwiGLU E{ws + WS_ACT, a.in[13] + (size_t)l * 32 * 2048};
                pg8::gemm_phase<true, true>(lds, tid, 512, S, E);
            } else if (sp == 8) {
                build_tab(cnt, TAB, tid);
                pg8::GroupedOrder S; S.init(ws + WS_ACT, ws + WS_WDN + (size_t)l * 32 * 1024 * 1024, TAB, 1024, 512, G, blockIdx.x);
                pg8::EpiDown E{(bf16_t*)(ws + WS_YBUF), a.in[15] + (size_t)l * 32 * 1024, (const int*)(ws + WS_ROWSLOT), (const float*)(ws + WS_ROWGATE), TAB, cnt};
                pg8::gemm_phase<false, true>(lds, tid, 512, S, E);
            } else {
                const bf16_t* x1r = (const bf16_t*)(ws + WS_X1B); const bf16_t* yb = (const bf16_t*)(ws + WS_YBUF); bf16_t* xb = (bf16_t*)(ws + WS_XB);
                const float* g2 = a.in[16] + l * 1024; const float* b2 = a.in[17] + l * 1024;
                f32x4 gv[4], bv[4];
#pragma unroll
                for (int j = 0; j < 4; ++j) { gv[j] = *(const f32x4*)(g2 + 4 * (64 * j + lane)); bv[j] = *(const f32x4*)(b2 + 4 * (64 * j + lane)); }
                for (int tok = gw; tok < NTOK; tok += NGW) { f32x4 v[4]; float s = 0.f;
#pragma unroll
                    for (int j = 0; j < 4; ++j) { const int co = 4 * (64 * j + lane); const u32x2 xr = *(const u32x2*)(x1r + (size_t)tok * 1024 + co); f32x4 x = (f32x4){bflo(xr.x), bfhi(xr.x), bflo(xr.y), bfhi(xr.y)} * DN_ALPHA;
#pragma unroll
                        for (int k = 0; k < 4; ++k) { const u32x2 w = *(const u32x2*)(yb + (size_t)(tok * 4 + k) * 1024 + co); x[0] += bflo(w.x); x[1] += bfhi(w.x); x[2] += bflo(w.y); x[3] += bfhi(w.y); }
                        v[j] = x; s += (x[0] + x[1]) + (x[2] + x[3]); }
                    const float mean = wave_sum(s, lane) * (1.f / 1024.f); float s2 = 0.f;
#pragma unroll
                    for (int j = 0; j < 4; ++j) { v[j] = v[j] - mean; s2 += (v[j][0] * v[j][0] + v[j][1] * v[j][1]) + (v[j][2] * v[j][2] + v[j][3] * v[j][3]); }
                    const float rstd = rsqrtf(wave_sum(s2, lane) * (1.f / 1024.f) + LN_EPS);
#pragma unroll
                    for (int j = 0; j < 4; ++j) { const int co = 4 * (64 * j + lane); const f32x4 y = v[j] * rstd * gv[j] + bv[j];
                        if (l + 1 == DEPTH) *(f32x4*)(a.out + (size_t)tok * 1024 + co) = y;
                        else { u32x2 w; w.x = pk2(y[0], y[1]); w.y = pk2(y[2], y[3]); *(u32x2*)(xb + (size_t)tok * 1024 + co) = w; } } }
            }
        }
    }
}
__global__ void __launch_bounds__(512, 2) mega(Args a) {
    extern __shared__ __attribute__((aligned(16))) unsigned char lds_raw[];
    LAS unsigned char* lds = (LAS unsigned char*)lds_raw;
    volatile LAS unsigned* stw = (volatile LAS unsigned*)(lds + XBST_OFF);
    if (threadIdx.x < 4) stw[threadIdx.x] = 0u;
    const int wave_s = __builtin_amdgcn_readfirstlane((int)(threadIdx.x >> 6));
    __syncthreads();
    XcdBarrier bar; bar.bar = (unsigned*)(a.ws + WS_BAR); bar.x = 0; bar.st = stw;
    if (a.coop) bar = xcd_barrier_post((unsigned*)(a.ws + WS_BAR), stw);
    for (int ph = a.ph_lo; ph < a.ph_hi; ++ph) {
        const int nrep = 1 + ((a.rep >> ph) & 1) * a.nrep;
        for (int rpt = 0; rpt < nrep; ++rpt) {
            unsigned zs = 0u; asm volatile("" : "+s"(zs));
            int tid = wave_s * 64 + (int)__builtin_amdgcn_mbcnt_hi(~0u, __builtin_amdgcn_mbcnt_lo(~0u, zs)); asm volatile("" : "+v"(tid));
            run_phase(a, ph, lds, tid, rpt);
            if (a.coop && (ph + 1 < a.ph_hi || rpt + 1 < nrep)) { if (a.coop == 2) cg::this_grid().sync(); else xcd_barrier(bar, tid); }
            else __syncthreads();
        }
    }
}
#ifdef MK_DIAG
template <int PH> __global__ void __launch_bounds__(512, 2) mega_one(Args a) {
    extern __shared__ __attribute__((aligned(16))) unsigned char lds_raw[];
    run_phase(a, PH, (LAS unsigned char*)lds_raw, threadIdx.x, 0);
}
template __global__ void mega_one<0>(Args); template __global__ void mega_one<1>(Args); template __global__ void mega_one<2>(Args); template __global__ void mega_one<3>(Args);
template __global__ void mega_one<4>(Args); template __global__ void mega_one<5>(Args); template __global__ void mega_one<6>(Args); template __global__ void mega_one<7>(Args);
template __global__ void mega_one<8>(Args); template __global__ void mega_one<9>(Args); template __global__ void mega_one<10>(Args);
#endif

#ifndef MK_REP
#define MK_REP 0
#endif
#ifndef MK_NREP
#define MK_NREP 1
#endif
#ifndef MK_MULTI
#define MK_MULTI 0
#endif
extern "C" void kernel_launch(void* const* d_in, const int* in_sizes, int n_in, void* d_out, int out_size, void* d_ws, size_t ws_size, hipStream_t stream) {
    static int grid = 0;
    if (grid == 0) {
        if (n_in != 18 || ws_size < WS_END) { fprintf(stderr, "kernel_launch: unexpected n_in %d or ws_size %zu (< %zu)\n", n_in, ws_size, (size_t)WS_END); grid = -1; return; }
        int dev = 0, cus = 0, per_cu = 0;
        hipGetDevice(&dev); hipDeviceGetAttribute(&cus, hipDeviceAttributeMultiprocessorCount, dev);
        if (hipFuncSetAttribute((const void*)mega, hipFuncAttributeMaxDynamicSharedMemorySize, LDS_BYTES) != hipSuccess) { fprintf(stderr, "kernel_launch: hipFuncSetAttribute failed\n"); grid = -1; return; }
        if (hipOccupancyMaxActiveBlocksPerMultiprocessor(&per_cu, (const void*)mega, 512, LDS_BYTES) != hipSuccess || per_cu < 1) { fprintf(stderr, "kernel_launch: occupancy query says %d\n", per_cu); per_cu = 1; }
        (void)hipGetLastError();
        grid = cus * 1;
    }
    if (grid < 0) return;
    Args a{};
    for (int i = 0; i < 18; ++i) a.in[i] = (const float*)d_in[i];
    a.out = (float*)d_out; a.ws = (unsigned char*)d_ws; a.rep = MK_REP; a.nrep = MK_NREP;
#if MK_MULTI
    for (int ph = 0; ph < 21; ++ph) { a.ph_lo = ph; a.ph_hi = ph + 1; a.coop = 0; hipLaunchKernelGGL(mega, dim3(grid), dim3(512), LDS_BYTES, stream, a); }
#else
    a.ph_lo = 0; a.ph_hi = 21; a.coop = 1;
    if (hipMemsetAsync((char*)d_ws + WS_BAR, 0, 16384, stream) != hipSuccess) { fprintf(stderr, "kernel_launch: memset of barrier words failed\n"); return; }
    void* args[] = {&a};
    hipError_t e = hipLaunchCooperativeKernel((const void*)mega, dim3(grid), dim3(512), args, LDS_BYTES, stream);
    if (e != hipSuccess) fprintf(stderr, "cooperative launch failed: %s (grid %d)\n", hipGetErrorString(e), grid);
#endif
}
```
